# Optimizing an MI355X kernel written in HIP

```python
import jax, jax.numpy as jnp
from jax import lax
import numpy as np

D_MODEL = 1024
BATCH = 4
SEQ = 4096
DEPTH = 1

CHUNK = 64
M_HEADS = 4
M_HEAD_DIM = D_MODEL // M_HEADS
M_WIDTH = M_HEADS * M_HEAD_DIM
CONV_K = 4
SGU_BLOCK = 128
SGU_GROUPS = 4
SGU_WIDTH = D_MODEL
SGU_GROUP_DIM = SGU_WIDTH // SGU_GROUPS
D_FF = 2816
PROJ_SIZES = (M_WIDTH, M_WIDTH, M_WIDTH, M_WIDTH, M_HEADS, M_HEADS, 2 * SGU_WIDTH, D_MODEL, D_MODEL)
N_PROJ = 4 * M_WIDTH + 2 * M_HEADS + 2 * SGU_WIDTH + 2 * D_MODEL
RMS_EPS = 1e-6
LN_EPS = 1e-5

kernel_name = "hybrid_mlstm_sgu_macaron_block"


def rmsnorm(x, g):
    x32 = x.astype(jnp.float32)
    y = x32 * lax.rsqrt(jnp.mean(x32 * x32, axis=-1, keepdims=True) + RMS_EPS)
    return (y * g.astype(jnp.float32)).astype(x.dtype)


def layernorm32(x, eps):
    x32 = x.astype(jnp.float32)
    xc = x32 - jnp.mean(x32, axis=-1, keepdims=True)
    return xc * lax.rsqrt(jnp.mean(xc * xc, axis=-1, keepdims=True) + eps)


def swiglu(x, w_in, w_out):
    gate, up = jnp.split(x @ w_in, 2, axis=-1)
    return (jax.nn.silu(gate) * up) @ w_out


def causal_depthwise_conv(x, w, b):
    y = lax.conv_general_dilated(
        x, w[:, None, :].astype(x.dtype), window_strides=(1,),
        padding=[(CONV_K - 1, 0)], dimension_numbers=('NWC', 'WIO', 'NWC'),
        feature_group_count=x.shape[-1])
    return y + b.astype(x.dtype)


def mlstm_chunkwise(q, k, v, log_i, log_f):
    bsz, nh, seqlen, dh = q.shape
    nc = seqlen // CHUNK

    def to_chunks(t):
        return jnp.moveaxis(t.reshape(bsz, nh, nc, CHUNK, *t.shape[3:]), 2, 0)

    causal = jnp.tril(jnp.ones((CHUNK, CHUNK), dtype=bool))

    def step(carry, xs):
        c_state, n_state, m_state = carry
        qc, kc, vc, lic, lfc = xs
        b = jnp.cumsum(lfc, axis=-1)
        a_inter = b + m_state[..., None]
        d = jnp.where(causal, b[..., :, None] - b[..., None, :] + lic[..., None, :], -jnp.inf)
        m_t = jnp.maximum(a_inter, jnp.max(d, axis=-1))
        w_inter = jnp.exp(a_inter - m_t)
        scores = jnp.einsum('bhtd,bhsd->bhts', qc, kc) * jnp.exp(d - m_t[..., None])
        num = (w_inter[..., None] * jnp.einsum('bhed,bhtd->bhte', c_state, qc)
               + jnp.einsum('bhts,bhse->bhte', scores, vc))
        den = w_inter * jnp.einsum('bhd,bhtd->bht', n_state, qc) + jnp.sum(scores, axis=-1)
        h = num / jnp.maximum(jnp.abs(den), jnp.exp(-m_t))[..., None]
        b_last = b[..., -1]
        g = b_last[..., None] - b + lic
        m_new = jnp.maximum(b_last + m_state, jnp.max(g, axis=-1))
        decay = jnp.exp(b_last + m_state - m_new)
        wk = jnp.exp(g - m_new[..., None])
        c_new = decay[..., None, None] * c_state + jnp.einsum('bhs,bhse,bhsd->bhed', wk, vc, kc)
        n_new = decay[..., None] * n_state + jnp.einsum('bhs,bhsd->bhd', wk, kc)
        return (c_new, n_new, m_new), h

    init = (jnp.zeros((bsz, nh, dh, dh), jnp.float32),
            jnp.zeros((bsz, nh, dh), jnp.float32),
            jnp.zeros((bsz, nh), jnp.float32))
    xs = (to_chunks(q), to_chunks(k), to_chunks(v), to_chunks(log_i), to_chunks(log_f))
    _, hs = lax.scan(step, init, xs)
    return jnp.moveaxis(hs, 0, 2).reshape(bsz, nh, seqlen, dh)


def mlstm_branch(q_pre, k_pre, v_pre, o_pre, i_pre, f_pre, conv_w, conv_b, b_i, b_f, head_g):
    bsz, seqlen, _ = q_pre.shape
    qk = jax.nn.silu(causal_depthwise_conv(jnp.concatenate([q_pre, k_pre], axis=-1), conv_w, conv_b))
    q, k = jnp.split(qk, 2, axis=-1)

    def heads(t):
        return t.reshape(bsz, seqlen, M_HEADS, M_HEAD_DIM).transpose(0, 2, 1, 3).astype(jnp.float32)

    log_i = (i_pre + b_i).astype(jnp.float32).transpose(0, 2, 1)
    log_f = jax.nn.log_sigmoid((f_pre + b_f).astype(jnp.float32)).transpose(0, 2, 1)
    h = mlstm_chunkwise(heads(q), heads(k) * (M_HEAD_DIM ** -0.5), heads(v_pre), log_i, log_f)
    h = layernorm32(h, LN_EPS).transpose(0, 2, 1, 3).reshape(bsz, seqlen, M_WIDTH)
    return (jax.nn.sigmoid(o_pre.astype(jnp.float32)) * h * head_g).astype(q_pre.dtype)


def sgu_branch(z_pre, norm_g, norm_b, w_s, b_s):
    bsz, seqlen, _ = z_pre.shape
    u, v = jnp.split(jax.nn.gelu(z_pre, approximate=False), 2, axis=-1)
    v = (layernorm32(v, LN_EPS) * norm_g + norm_b).astype(z_pre.dtype)
    nb = seqlen // SGU_BLOCK
    v = v.reshape(bsz, nb, SGU_BLOCK, SGU_GROUPS, SGU_GROUP_DIM)
    chunk_id = jnp.arange(SGU_BLOCK) // CHUNK
    mask = chunk_id[:, None] >= chunk_id[None, :]
    w = jnp.where(mask, w_s, 0.0).astype(v.dtype)
    sv = jnp.einsum('gts,bnsgc->bntgc', w, v) + b_s.T[:, :, None].astype(v.dtype)
    return u * sv.reshape(bsz, seqlen, SGU_WIDTH)


def setup_inputs(seed: int = 0) -> dict:
    key = jax.random.key(seed)
    ks = jax.random.split(key, 20)
    L = DEPTH

    def nrm(k, shape, scale):
        return jax.random.normal(k, shape, jnp.float32) * scale

    return {
        'x': nrm(ks[0], (BATCH, SEQ, D_MODEL), 1.0),
        'ffn1_norm_g': 1.0 + nrm(ks[1], (L, D_MODEL), 0.05),
        'ffn1_w_in': nrm(ks[2], (L, D_MODEL, 2 * D_FF), D_MODEL ** -0.5),
        'ffn1_w_out': nrm(ks[3], (L, D_FF, D_MODEL), D_FF ** -0.5),
        'mix_norm_g': 1.0 + nrm(ks[4], (L, D_MODEL), 0.05),
        'w_mix_in': nrm(ks[5], (L, D_MODEL, N_PROJ), D_MODEL ** -0.5),
        'mlstm_conv_w': nrm(ks[6], (L, CONV_K, 2 * M_WIDTH), CONV_K ** -0.5),
        'mlstm_conv_b': nrm(ks[7], (L, 2 * M_WIDTH), 0.01),
        'mlstm_b_igate': nrm(ks[8], (L, M_HEADS), 0.1),
        'mlstm_b_fgate': jnp.linspace(3.0, 6.0, M_HEADS, dtype=jnp.float32) + nrm(ks[9], (L, M_HEADS), 0.1),
        'mlstm_head_norm_g': 1.0 + nrm(ks[10], (L, M_WIDTH), 0.05),
        'sgu_norm_g': 1.0 + nrm(ks[11], (L, SGU_WIDTH), 0.05),
        'sgu_norm_b': nrm(ks[12], (L, SGU_WIDTH), 0.01),
        'sgu_w_s': nrm(ks[13], (L, SGU_GROUPS, SGU_BLOCK, SGU_BLOCK), SGU_BLOCK ** -0.5),
        'sgu_b_s': 1.0 + nrm(ks[14], (L, SGU_GROUPS, SGU_BLOCK), 0.1),
        'w_mix_out': nrm(ks[15], (L, D_MODEL, D_MODEL), D_MODEL ** -0.5),
        'ffn2_norm_g': 1.0 + nrm(ks[16], (L, D_MODEL), 0.05),
        'ffn2_w_in': nrm(ks[17], (L, D_MODEL, 2 * D_FF), D_MODEL ** -0.5),
        'ffn2_w_out': nrm(ks[18], (L, D_FF, D_MODEL), D_FF ** -0.5),
        'final_norm_g': 1.0 + nrm(ks[19], (D_MODEL,), 0.05),
    }


def reference(x, ffn1_norm_g, ffn1_w_in, ffn1_w_out, mix_norm_g, w_mix_in, mlstm_conv_w, mlstm_conv_b,
              mlstm_b_igate, mlstm_b_fgate, mlstm_head_norm_g, sgu_norm_g, sgu_norm_b, sgu_w_s, sgu_b_s,
              w_mix_out, ffn2_norm_g, ffn2_w_in, ffn2_w_out, final_norm_g):
    split_idx = np.cumsum(PROJ_SIZES)[:-1].tolist()
    for l in range(DEPTH):
        x = x + 0.5 * swiglu(rmsnorm(x, ffn1_norm_g[l]), ffn1_w_in[l], ffn1_w_out[l])
        xn = rmsnorm(x, mix_norm_g[l])
        proj = xn @ w_mix_in[l]
        q_pre, k_pre, v_pre, o_pre, i_pre, f_pre, z_pre, gate_m, gate_s = jnp.split(proj, split_idx, axis=-1)
        h_m = mlstm_branch(q_pre, k_pre, v_pre, o_pre, i_pre, f_pre, mlstm_conv_w[l], mlstm_conv_b[l],
                           mlstm_b_igate[l], mlstm_b_fgate[l], mlstm_head_norm_g[l])
        h_s = sgu_branch(z_pre, sgu_norm_g[l], sgu_norm_b[l], sgu_w_s[l], sgu_b_s[l])
        merged = jax.nn.sigmoid(gate_m) * h_m + jax.nn.sigmoid(gate_s) * h_s
        x = x + merged @ w_mix_out[l]
        x = x + 0.5 * swiglu(rmsnorm(x, ffn2_norm_g[l]), ffn2_w_in[l], ffn2_w_out[l])
    return rmsnorm(x, final_norm_g)
```

```cpp
#include <hip/hip_runtime.h>
#include <hip/hip_cooperative_groups.h>
#include <cstdio>
namespace cg = cooperative_groups;
#ifndef MK_SINGLE
#define MK_SINGLE 1
#endif
#include <hip/hip_runtime.h>
namespace pg8 {
#define PG8_LAS __attribute__((address_space(3)))
typedef unsigned short bf16_t;
typedef short bf16x8 __attribute__((ext_vector_type(8)));
typedef float f32x4 __attribute__((ext_vector_type(4)));
typedef unsigned u32x4 __attribute__((ext_vector_type(4)));
constexpr int BM = 256, BK = 64, HALF = 128, HTB = HALF * BK * 2  , STAGE_BYTES = 8 * HTB, NXCD = 8, WGM = 8;

__host__ __device__ __forceinline__ int lds_byte(int r, int c) { const int st = (r >> 4) * 2 + (c >> 5), rr = r & 15, cc = c & 31, ob = rr * 64 + cc * 2; return st * 1024 + (ob ^ (((ob >> 9) & 1) << 5)); }
__host__ __device__ __forceinline__ void stage_rc(int b, int& R, int& C) { const int st = b / 1024, sb = b % 1024, swz = sb ^ (((sb >> 9) & 1) << 5); R = (st >> 1) * 16 + swz / 64; C = (st & 1) * 32 + (swz % 64) / 2; }
__host__ __device__ __forceinline__ int perm32(int rho) { const int n = rho >> 4, i = rho & 15; return 8 * (i >> 2) + 4 * n + (i & 3); }

struct Unit { int pm, pn; };
struct Gemm { const bf16_t* A; const bf16_t* Bt; int M, N, K; };

struct StaticOrder {
    int nM, nN, nwg, G, c;
    __host__ __device__ void init(int M, int N, int G_, int c_) { nM = M / BM; nN = N / BM; nwg = nM * nN; G = G_; c = c_; }
    __host__ __device__ bool next(int i, Unit& u) const {
        const long L = (long)i * G + c; if (L >= nwg) return false;
        int wgid = (int)L; { const int q = nwg / NXCD, r = nwg % NXCD, xcd = wgid % NXCD, off = wgid / NXCD; wgid = (xcd < r ? xcd * (q + 1) : r * (q + 1) + (xcd - r) * q) + off; }
        const int nig = WGM * nN, gid = wgid / nig, fm = gid * WGM, gsz = (nM - fm) < WGM ? (nM - fm) : WGM;
        u.pm = fm + ((wgid % nig) % gsz); u.pn = (wgid % nig) / gsz; return true;
    }
    __device__ __forceinline__ void a_ready(const Unit&) const {}
    __device__ __forceinline__ void done(const Unit&) const {}
};

typedef float f32x2 __attribute__((ext_vector_type(2)));
typedef __bf16 bf16x2_t __attribute__((ext_vector_type(2)));
typedef unsigned u32x2 __attribute__((ext_vector_type(2)));
__device__ __forceinline__ unsigned cvt_pk_bf16(float lo, float hi) { f32x2 v = {lo, hi}; bf16x2_t b = __builtin_convertvector(v, bf16x2_t); return __builtin_bit_cast(unsigned, b); }
__device__ __forceinline__ f32x2 gelu_pk(f32x2 v) {
    const f32x2 av = __builtin_elementwise_abs(v), d = av * 0.2316418882f + 1.0f;
    f32x2 t; t.x = __builtin_amdgcn_rcpf(d.x); t.y = __builtin_amdgcn_rcpf(d.y);
    f32x2 q = t * 0.5307027145f + (-0.7265760135f); q = q * t + 0.7107068705f; q = q * t + (-0.142248368f); q = q * t + 0.127414796f; q = q * t;
    const f32x2 s = (v * v) * (-0.72134752044f);
    f32x2 e; e.x = __builtin_amdgcn_exp2f(s.x); e.y = __builtin_amdgcn_exp2f(s.y);
    const f32x2 m = v * (q * e), r = v - m;
    f32x2 o; o.x = v.x < 0.f ? m.x : r.x; o.y = v.y < 0.f ? m.y : r.y; return o;
}
__device__ __forceinline__ f32x4 gelu4(f32x4 v) { f32x2 a = gelu_pk((f32x2){v[0], v[1]}), b = gelu_pk((f32x2){v[2], v[3]}); return (f32x4){a.x, a.y, b.x, b.y}; }
__device__ __forceinline__ float sigm(float x) { return __builtin_amdgcn_rcpf(1.0f + __expf(-x)); }
__device__ __forceinline__ f32x4 sigm4(f32x4 v) { return (f32x4){sigm(v[0]), sigm(v[1]), sigm(v[2]), sigm(v[3])}; }
__device__ __forceinline__ u32x4 pack8(f32x4 a, f32x4 b) { u32x4 w; w.x = cvt_pk_bf16(a[0], a[1]); w.y = cvt_pk_bf16(a[2], a[3]); w.z = cvt_pk_bf16(b[0], b[1]); w.w = cvt_pk_bf16(b[2], b[3]); return w; }

struct EpiSwiGLU {
    static constexpr bool PERM = true, AFTER_DRAIN = false;
    bf16_t* H; const float* rstd; int ldh;
    __device__ __forceinline__ void operator()(const f32x4 (&acc)[2][2][4][2], const Unit& u, int wr, int wc, int fr, int fq) const {
        const int row0 = u.pm * BM + wr * 64 + fr, col0 = u.pn * 128 + wc * 32 + 8 * fq;
#pragma unroll
        for (int ai = 0; ai < 2; ++ai)
#pragma unroll
            for (int m = 0; m < 4; ++m) { const int row = row0 + ai * HALF + m * 16; const float rs = rstd[row];
                f32x4 h[2];
#pragma unroll
                for (int n = 0; n < 2; ++n) { const f32x4 g = acc[ai][0][m][n] * rs, up = acc[ai][1][m][n] * rs; h[n] = g * sigm4(g) * up; }
                *(u32x4*)(H + (size_t)row * ldh + col0) = pack8(h[0], h[1]); }
    }
};
struct EpiResid {
    static constexpr bool PERM = false, AFTER_DRAIN = false;
    const float* base; float* out; bf16_t* xb; float alpha;
    __device__ __forceinline__ void operator()(const f32x4 (&acc)[2][2][4][2], const Unit& u, int wr, int wc, int fr, int fq) const {
        const int row0 = u.pm * BM + wr * 64 + fr, col0 = u.pn * BM + wc * 32 + 4 * fq;
#pragma unroll
        for (int ai = 0; ai < 2; ++ai)
#pragma unroll
            for (int m = 0; m < 4; ++m) { const size_t off = (size_t)(row0 + ai * HALF + m * 16) * 1024 + col0;
#pragma unroll
                for (int bj = 0; bj < 2; ++bj)
#pragma unroll
                    for (int n = 0; n < 2; ++n) { const size_t o2 = off + bj * HALF + n * 16; const f32x4 bs = *(const f32x4*)(base + o2); const f32x4 o = bs + acc[ai][bj][m][n] * alpha;
                        *(f32x4*)(out + o2) = o;
                        if (xb) { u32x2 w; w.x = cvt_pk_bf16(o[0], o[1]); w.y = cvt_pk_bf16(o[2], o[3]); *(u32x2*)(xb + o2) = w; } } }
    }
};
struct EpiMixA {
    static constexpr bool PERM = true, AFTER_DRAIN = false;
    bf16_t* UG; bf16_t* ZV; const float* rstd;
    __device__ __forceinline__ void operator()(const f32x4 (&acc)[2][2][4][2], const Unit& u, int wr, int wc, int fr, int fq) const {
        const int row0 = u.pm * BM + wr * 64 + fr, cw = wc * 32 + 8 * fq;
#pragma unroll
        for (int ai = 0; ai < 2; ++ai)
#pragma unroll
            for (int m = 0; m < 4; ++m) { const int row = row0 + ai * HALF + m * 16; const float rs = rstd[row];
                if (u.pn < 8) {
                    f32x4 h[2];
#pragma unroll
                    for (int n = 0; n < 2; ++n) h[n] = gelu4(acc[ai][0][m][n] * rs) * sigm4(acc[ai][1][m][n] * rs);
                    *(u32x4*)(UG + (size_t)row * 1024 + u.pn * 128 + cw) = pack8(h[0], h[1]);
                } else {
#pragma unroll
                    for (int bj = 0; bj < 2; ++bj)
                        *(u32x4*)(ZV + (size_t)row * 1024 + (u.pn - 8) * 256 + bj * HALF + cw) = pack8(gelu4(acc[ai][bj][m][0] * rs), gelu4(acc[ai][bj][m][1] * rs));
                } }
    }
};
struct EpiMixB {
    static constexpr bool PERM = true, AFTER_DRAIN = false;
    bf16_t* QKV; size_t tstride; bf16_t* OGM; bf16_t* HALO; const float* rstd;
    __device__ __forceinline__ void operator()(const f32x4 (&acc)[2][2][4][2], const Unit& u, int wr, int wc, int fr, int fq) const {
        const int row0 = u.pm * BM + wr * 64 + fr, cw = wc * 32 + 8 * fq;
#pragma unroll
        for (int ai = 0; ai < 2; ++ai)
#pragma unroll
            for (int m = 0; m < 4; ++m) { const int row = row0 + ai * HALF + m * 16; const float rs = rstd[row];
                if (u.pn < 12) {
                    const int reg = u.pn >> 2, ct = (u.pn & 3) * 256;
#pragma unroll
                    for (int bj = 0; bj < 2; ++bj) { const u32x4 w = pack8(acc[ai][bj][m][0] * rs, acc[ai][bj][m][1] * rs); const int col = ct + bj * HALF + cw;
                        *(u32x4*)(QKV + (size_t)reg * tstride + (size_t)row * 1024 + col) = w;
                        if (reg < 2 && (row & 63) >= 61) *(u32x4*)(HALO + ((size_t)(row >> 6) * 3 + ((row & 63) - 61)) * 2048 + reg * 1024 + col) = w; }
                } else {
                    f32x4 h[2];
#pragma unroll
                    for (int n = 0; n < 2; ++n) h[n] = sigm4(acc[ai][0][m][n] * rs) * sigm4(acc[ai][1][m][n] * rs);
                    *(u32x4*)(OGM + (size_t)row * 1024 + (u.pn - 12) * 128 + cw) = pack8(h[0], h[1]);
                } }
    }
};

template <class Epi, class Sched, bool STAMP = false>
__device__ __forceinline__ void gemm_phase(PG8_LAS unsigned char* lds, const Gemm g, const Sched& S, const Epi& E, unsigned long long* stamps) {
    const int tid = threadIdx.x, wid = __builtin_amdgcn_readfirstlane(tid >> 6), lane = tid & 63, wr = wid >> 2, wc = wid & 3, fr = lane & 15, fq = lane >> 4;
    const int K = g.K, nt = K / BK;
    int ts_lo = 0, ts_hi = 0, nts = 0; const unsigned long long rt_entry = STAMP ? (unsigned long long)wall_clock64() : 0ull;
#define PG8_STAMP() do { if (STAMP && wid == 0 && nts < 64) { const unsigned long long _c = (unsigned long long)clock64(); \
        ts_lo = (lane == nts) ? (int)(unsigned)_c : ts_lo; ts_hi = (lane == nts) ? (int)(unsigned)(_c >> 32) : ts_hi; ++nts; } } while (0)
    PG8_STAMP();
    unsigned voffA[2], voffB[2];
#pragma unroll
    for (int i = 0; i < 2; ++i) { int R, C; stage_rc(tid * 16 + i * 8192, R, C); const int Rb = Epi::PERM ? ((R & ~31) + perm32(R & 31)) : R;
        voffA[i] = (unsigned)(R * K + C) * 2u; voffB[i] = (unsigned)(Rb * K + C) * 2u; }
    const size_t kstep = (size_t)(BK * 2);
    const size_t hstep = (size_t)HALF * K * 2;
    const size_t tstep = 2 * hstep;
    const unsigned ldsw = (unsigned)wid * 1024u;
    const int aoff = lds_byte(wr * 64 + fr, fq * 8), boff = lds_byte(wc * 32 + fr, fq * 8);
#define PG8_SA(b, h) (((b) * 2 + (h)) * HTB)
#define PG8_SB(b, h) ((4 + (b) * 2 + (h)) * HTB)
#define PG8_STAGE(bufoff, gbase, voff) do { _Pragma("unroll") for (int _i = 0; _i < 2; ++_i) \
        __builtin_amdgcn_global_load_lds((const unsigned*)((const char*)(gbase) + (voff)[_i]), (PG8_LAS unsigned*)(lds + (bufoff) + ldsw + _i * 8192), 16, 0, 0); } while (0)
#define PG8_LDA(dst, b, h) do { _Pragma("unroll") for (int m = 0; m < 4; ++m) _Pragma("unroll") for (int k = 0; k < 2; ++k) dst[m][k] = *(const PG8_LAS bf16x8*)(lds + PG8_SA(b, h) + aoff + m * 2048 + k * 1024); } while (0)
#define PG8_LDB(dst, b, h) do { _Pragma("unroll") for (int n = 0; n < 2; ++n) _Pragma("unroll") for (int k = 0; k < 2; ++k) dst[n][k] = *(const PG8_LAS bf16x8*)(lds + PG8_SB(b, h) + boff + n * 2048 + k * 1024); } while (0)
#define PG8_MMA(ai, bj, At, Bt) do { __builtin_amdgcn_s_setprio(1); _Pragma("unroll") for (int m = 0; m < 4; ++m) _Pragma("unroll") for (int n = 0; n < 2; ++n) _Pragma("unroll") for (int k = 0; k < 2; ++k) \
        acc[ai][bj][m][n] = __builtin_amdgcn_mfma_f32_16x16x32_bf16(Bt[n][k], At[m][k], acc[ai][bj][m][n], 0, 0, 0); __builtin_amdgcn_s_setprio(0); } while (0)
#define PG8_WAIT_V(n) asm volatile("s_waitcnt vmcnt(" #n ")" ::: "memory")
#define PG8_WAIT_L(n) asm volatile("s_waitcnt lgkmcnt(" #n ")" ::: "memory")
#define PG8_BAR __builtin_amdgcn_s_barrier()
#define PG8_SCHED __builtin_amdgcn_sched_barrier(0)
    Unit cur, nxt; int ui = 0;
    if (!S.next(0, cur)) return;
    f32x4 acc[2][2][4][2];
#pragma unroll
    for (int a = 0; a < 2; ++a)
#pragma unroll
        for (int b = 0; b < 2; ++b)
#pragma unroll
            for (int m = 0; m < 4; ++m)
#pragma unroll
                for (int n = 0; n < 2; ++n) acc[a][b][m][n] = (f32x4){0.f, 0.f, 0.f, 0.f};
    bf16x8 At[4][2], B0[2][2], B1[2][2];
    const char* cA = (const char*)g.A + (size_t)cur.pm * tstep; const char* cB = (const char*)g.Bt + (size_t)cur.pn * tstep;
    S.a_ready(cur);
    PG8_STAGE(PG8_SB(0, 0), cB, voffB); PG8_STAGE(PG8_SA(0, 0), cA, voffA); PG8_STAGE(PG8_SB(0, 1), cB + hstep, voffB); PG8_STAGE(PG8_SA(0, 1), cA + hstep, voffA);
    if (wr == 1) PG8_BAR;
    PG8_WAIT_V(4); PG8_BAR;
    PG8_STAGE(PG8_SB(1, 0), cB + kstep, voffB); PG8_STAGE(PG8_SA(1, 0), cA + kstep, voffA); PG8_STAGE(PG8_SB(1, 1), cB + hstep + kstep, voffB);
    PG8_WAIT_V(6); PG8_BAR;
    PG8_STAMP();
    for (;;) {
        const bool has_next = S.next(ui + 1, nxt);
        const char* nA = has_next ? (const char*)g.A + (size_t)nxt.pm * tstep : cA; const char* nB = has_next ? (const char*)g.Bt + (size_t)nxt.pn * tstep : cB;
        for (int t = 0; t < nt; t += 2) {
            const bool last = (t == nt - 2);
            const char* a1 = cA + (size_t)(t + 1) * kstep;
            const char* a2 = last ? nA : cA + (size_t)(t + 2) * kstep; const char* b2 = last ? nB : cB + (size_t)(t + 2) * kstep;
            const char* a3 = a2 + kstep; const char* b3 = b2 + kstep;
            if (last && has_next) S.a_ready(nxt);
            PG8_LDB(B0, 0, 0); PG8_SCHED; PG8_LDA(At, 0, 0); PG8_STAGE(PG8_SA(1, 1), a1 + hstep, voffA);
            PG8_WAIT_L(8); PG8_BAR; PG8_WAIT_L(0); PG8_MMA(0, 0, At, B0); PG8_BAR; PG8_SCHED;
            PG8_LDB(B1, 0, 1); PG8_STAGE(PG8_SB(0, 0), b2, voffB);
            PG8_BAR; PG8_WAIT_L(0); PG8_MMA(0, 1, At, B1); PG8_BAR;
            PG8_LDA(At, 0, 1); PG8_STAGE(PG8_SA(0, 0), a2, voffA);
            PG8_BAR; PG8_WAIT_L(0); PG8_MMA(1, 0, At, B0); PG8_BAR; PG8_SCHED;
            PG8_STAGE(PG8_SB(0, 1), b2 + hstep, voffB);
            PG8_WAIT_V(6); PG8_BAR; PG8_MMA(1, 1, At, B1); PG8_BAR;
            PG8_LDB(B0, 1, 0); PG8_SCHED; PG8_LDA(At, 1, 0); PG8_STAGE(PG8_SA(0, 1), a2 + hstep, voffA);
            PG8_WAIT_L(8); PG8_BAR; PG8_WAIT_L(0); PG8_MMA(0, 0, At, B0); PG8_BAR; PG8_SCHED;
            PG8_LDB(B1, 1, 1); PG8_STAGE(PG8_SB(1, 0), b3, voffB);
            PG8_BAR; PG8_WAIT_L(0); PG8_MMA(0, 1, At, B1); PG8_BAR;
            PG8_LDA(At, 1, 1); PG8_STAGE(PG8_SA(1, 0), a3, voffA);
            PG8_BAR; PG8_WAIT_L(0); PG8_MMA(1, 0, At, B0); PG8_BAR; PG8_SCHED;
            PG8_STAGE(PG8_SB(1, 1), b3 + hstep, voffB);
            PG8_WAIT_V(6); PG8_BAR; PG8_MMA(1, 1, At, B1); PG8_BAR;
        }
        PG8_STAMP();
        if constexpr (!Epi::AFTER_DRAIN) { E(acc, cur, wr, wc, fr, fq); S.done(cur); }
        PG8_STAMP();
        if (!has_next) break;
#pragma unroll
        for (int a = 0; a < 2; ++a)
#pragma unroll
            for (int b = 0; b < 2; ++b)
#pragma unroll
                for (int m = 0; m < 4; ++m)
#pragma unroll
                    for (int n = 0; n < 2; ++n) acc[a][b][m][n] = (f32x4){0.f, 0.f, 0.f, 0.f};
        cur = nxt; cA = nA; cB = nB; ++ui;
    }
    PG8_WAIT_V(0);
    if (wr == 0) PG8_BAR;
    PG8_BAR;
    if constexpr (Epi::AFTER_DRAIN) { E.fused(acc, cur, wr, wc, fr, fq, lds, wid, lane); S.done(cur); }
    PG8_STAMP();
    if (STAMP && wid == 0) { stamps[lane] = lane < nts ? (((unsigned long long)(unsigned)ts_hi << 32) | (unsigned)ts_lo) : 0ull;
        if (lane == 62) stamps[62] = rt_entry; if (lane == 63) stamps[63] = (unsigned long long)wall_clock64(); }
#undef PG8_STAMP
#undef PG8_SA
#undef PG8_SB
#undef PG8_STAGE
#undef PG8_LDA
#undef PG8_LDB
#undef PG8_MMA
#undef PG8_WAIT_V
#undef PG8_WAIT_L
#undef PG8_BAR
#undef PG8_SCHED
}
}

#define LAS __attribute__((address_space(3)))
using pg8::bf16_t; using pg8::bf16x8; using pg8::f32x4; using pg8::u32x4; using pg8::f32x2; using pg8::u32x2; using pg8::cvt_pk_bf16;
constexpr int T = 16384, D = 1024, FF = 2816, SEQ = 4096, NTHR = 512, NWAVE = 8;
constexpr size_t MiB = 1u << 20;
constexpr size_t WS_R0 = 0 * MiB;
constexpr size_t WS_R1 = 32 * MiB;
constexpr size_t WS_R2 = 64 * MiB;
constexpr size_t WS_R3 = 96 * MiB;
constexpr size_t WS_R4 = 128 * MiB;
constexpr size_t WS_R5 = 160 * MiB;
constexpr size_t WS_H = 32 * MiB;
constexpr size_t WS_S = 192 * MiB;
constexpr size_t WS_W1I = 200 * MiB;
constexpr size_t WS_W1O = 211 * MiB;
constexpr size_t WS_WMX = WS_W1O + 5632 * 1024;
constexpr size_t WS_WO = WS_WMX + 16 * MiB;
constexpr size_t WS_W2I = WS_WO + 2 * MiB;
constexpr size_t WS_W2O = WS_W2I + 11 * MiB;
constexpr size_t WS_HALO = WS_W2O + 5632 * 1024;
constexpr size_t WS_LI = WS_HALO + 3 * MiB;
constexpr size_t WS_LF = WS_LI + 256 * 1024;
constexpr size_t WS_WIF = WS_LF + 256 * 1024;
constexpr size_t WS_WSG = WS_WIF + 32 * 1024;
constexpr size_t WS_RSTD = WS_WSG + 128 * 1024;
constexpr size_t WS_EN = WS_RSTD + 64 * 1024;
constexpr size_t WS_RS = WS_EN + 256 * 1024;
constexpr size_t WS_DEC = WS_RS + 256 * 1024;
constexpr size_t WS_END = WS_DEC + 4096;
static_assert(WS_END <= 256 * MiB, "workspace map exceeds 256 MiB");
constexpr int LDS_BYTES = 147456;

struct Params { const float* in[20]; float* out; unsigned char* ws; int ph_lo, ph_hi; };

__device__ __forceinline__ float bf2f(unsigned short b) { return __uint_as_float(((unsigned)b) << 16); }
__device__ __forceinline__ float bflo(unsigned w) { return __uint_as_float(w << 16); }
__device__ __forceinline__ float bfhi(unsigned w) { return __uint_as_float(w & 0xffff0000u); }
__device__ __forceinline__ void unpack8(const u32x4 w, float (&f)[8]) { f[0] = bflo(w.x); f[1] = bfhi(w.x); f[2] = bflo(w.y); f[3] = bfhi(w.y); f[4] = bflo(w.z); f[5] = bfhi(w.z); f[6] = bflo(w.w); f[7] = bfhi(w.w); }
__device__ __forceinline__ float wave_sum(float v) {
#pragma unroll
    for (int o = 1; o < 64; o <<= 1) v += __shfl_xor(v, o);
    return v; }
__device__ __forceinline__ float wave_max(float v) {
#pragma unroll
    for (int o = 1; o < 64; o <<= 1) v = fmaxf(v, __shfl_xor(v, o));
    return v; }
__device__ __forceinline__ float wave_scan_sum(float v, int lane) {
#pragma unroll
    for (int o = 1; o < 64; o <<= 1) { const float t = __shfl_up(v, o); if (lane >= o) v += t; }
    return v; }
__device__ __forceinline__ float wave_scan_max(float v, int lane) {
#pragma unroll
    for (int o = 1; o < 64; o <<= 1) { const float t = __shfl_up(v, o); if (lane >= o) v = fmaxf(v, t); }
    return v; }
#define LDS_FENCE() asm volatile("s_waitcnt lgkmcnt(0)" ::: "memory")

__device__ __forceinline__ int map_ffn_in(int n) { const int j = n >> 8, r = n & 255; return r < 128 ? 128 * j + r : FF + 128 * j + (r - 128); }
__device__ __forceinline__ int map_mix(int n) {
    if (n < 2048) { const int j = n >> 8, r = n & 255; return r < 128 ? 4104 + 128 * j + r : 7176 + 128 * j + (r - 128); }
    if (n < 3072) return 5128 + (n - 2048);
    n -= 3072;
    if (n < 3072) return n;
    n -= 3072; { const int j = n >> 8, r = n & 255; return r < 128 ? 3072 + 128 * j + r : 6152 + 128 * j + (r - 128); }
}
__device__ __forceinline__ void tr_item(const float* W, int Nsrc, int K, int k0, int srccol0, const float* ksc, bf16_t* WT, int n0, LAS float* scr, int lane) {
#pragma unroll 8
    for (int i = 0; i < 32; ++i) { const int kk = 2 * i + (lane >> 5); float v = W[(size_t)(k0 + kk) * Nsrc + srccol0 + (lane & 31)]; if (ksc) v *= ksc[k0 + kk]; scr[kk * 33 + (lane & 31)] = v; }
    LDS_FENCE();
    const int c = lane & 7;
#pragma unroll
    for (int j = 0; j < 4; ++j) { const int n = (lane >> 3) + 8 * j; const LAS float* s = scr + (8 * c) * 33 + n;
        u32x4 o; o.x = cvt_pk_bf16(s[0 * 33], s[1 * 33]); o.y = cvt_pk_bf16(s[2 * 33], s[3 * 33]); o.z = cvt_pk_bf16(s[4 * 33], s[5 * 33]); o.w = cvt_pk_bf16(s[6 * 33], s[7 * 33]);
        *(u32x4*)(WT + (size_t)(n0 + n) * K + k0 + 8 * c) = o; }
    LDS_FENCE();
}
__device__ __forceinline__ float row_rstd(const float* xrow, bf16_t* brow, int lane) {
    const f32x4* xr = (const f32x4*)xrow + lane; f32x4 v[4]; float s = 0.f;
#pragma unroll
    for (int j = 0; j < 4; ++j) { v[j] = xr[64 * j]; s += (v[j].x * v[j].x + v[j].y * v[j].y) + (v[j].z * v[j].z + v[j].w * v[j].w); }
    s = wave_sum(s);
    if (brow) { u32x2* o = (u32x2*)brow + lane;
#pragma unroll
        for (int j = 0; j < 4; ++j) { u32x2 w; w.x = cvt_pk_bf16(v[j].x, v[j].y); w.y = cvt_pk_bf16(v[j].z, v[j].w); o[64 * j] = w; } }
    return 1.0f / sqrtf(s * (1.0f / 1024.0f) + 1e-6f);
}
__device__ __forceinline__ void p0_prologue(const Params& P, LAS unsigned char* lds, int tid, int wave, int lane) {
    unsigned char* ws = P.ws;
    LAS float* scr = (LAS float*)(lds + wave * 16384);
    const int gw = blockIdx.x * NWAVE + wave, NGW = gridDim.x * NWAVE;
    constexpr int I1 = 16 * 176, I2 = 44 * 32, I3 = 16 * 256, I4 = 16 * 32;
    constexpr int NIT = 2 * I1 + 2 * I2 + I3 + I4;
    for (int it = gw; it < NIT; it += NGW) {
        int r = it;
        if (r < I1) { const int kb = r / 176, nb = r % 176; tr_item(P.in[2], 2 * FF, D, 64 * kb, map_ffn_in(32 * nb), P.in[1], (bf16_t*)(ws + WS_W1I), 32 * nb, scr, lane); continue; } r -= I1;
        if (r < I1) { const int kb = r / 176, nb = r % 176; tr_item(P.in[17], 2 * FF, D, 64 * kb, map_ffn_in(32 * nb), P.in[16], (bf16_t*)(ws + WS_W2I), 32 * nb, scr, lane); continue; } r -= I1;
        if (r < I2) { const int kb = r / 32, nb = r % 32; tr_item(P.in[3], D, FF, 64 * kb, 32 * nb, nullptr, (bf16_t*)(ws + WS_W1O), 32 * nb, scr, lane); continue; } r -= I2;
        if (r < I2) { const int kb = r / 32, nb = r % 32; tr_item(P.in[18], D, FF, 64 * kb, 32 * nb, nullptr, (bf16_t*)(ws + WS_W2O), 32 * nb, scr, lane); continue; } r -= I2;
        if (r < I3) { const int kb = r / 256, nb = r % 256; tr_item(P.in[5], 8200, D, 64 * kb, map_mix(32 * nb), P.in[4], (bf16_t*)(ws + WS_WMX), 32 * nb, scr, lane); continue; } r -= I3;
        { const int kb = r / 32, nb = r % 32; tr_item(P.in[15], D, D, 64 * kb, 32 * nb, nullptr, (bf16_t*)(ws + WS_WO), 32 * nb, scr, lane); }
    }
    { float* wif = (float*)(ws + WS_WIF); const float* wm = P.in[5]; const float* g = P.in[4];
      for (int i = blockIdx.x * NTHR + tid; i < 8 * 1024; i += gridDim.x * NTHR) { const int j = i >> 10, k = i & 1023; wif[i] = wm[(size_t)k * 8200 + 4096 + j] * g[k]; } }
    { bf16_t* wsg = (bf16_t*)(ws + WS_WSG); const float* w = P.in[13];
      for (int i = blockIdx.x * NTHR + tid; i < 4 * 128 * 128; i += gridDim.x * NTHR) { const int t = (i >> 7) & 127, s = i & 127; const float v = ((t >> 6) >= (s >> 6)) ? w[i] : 0.f; wsg[i] = (bf16_t)(cvt_pk_bf16(v, 0.f) & 0xffffu); } }
    { float* rstd = (float*)(ws + WS_RSTD); bf16_t* xb = (bf16_t*)(ws + WS_R0);
      for (int m = gw; m < T; m += NGW) { const float r = row_rstd(P.in[0] + (size_t)m * D, xb + (size_t)m * D, lane); if (lane == 0) rstd[m] = r; } }
}

__device__ __forceinline__ void row_phase(const Params& P, const bool gates, int wave, int lane) {
    unsigned char* ws = P.ws; float* rstd = (float*)(ws + WS_RSTD); const float* xr = P.out;
    const float* wif = (const float*)(ws + WS_WIF); float* LI = (float*)(ws + WS_LI); float* LF = (float*)(ws + WS_LF);
    const int gw = blockIdx.x * NWAVE + wave, NGW = gridDim.x * NWAVE;
    for (int m = gw; m < T; m += NGW) {
        const f32x4* xp = (const f32x4*)(xr + (size_t)m * D) + lane; f32x4 v[4]; float s = 0.f;
#pragma unroll
        for (int j = 0; j < 4; ++j) { v[j] = xp[64 * j]; s += (v[j].x * v[j].x + v[j].y * v[j].y) + (v[j].z * v[j].z + v[j].w * v[j].w); }
        s = wave_sum(s);
        const float rs = 1.0f / sqrtf(s * (1.0f / 1024.0f) + 1e-6f);
        if (lane == 0) rstd[m] = rs;
        if (gates) {
            float myv = 0.f;
#pragma unroll
            for (int g = 0; g < 8; ++g) { const f32x4* wp = (const f32x4*)(wif + g * 1024) + lane; float d = 0.f;
#pragma unroll
                for (int j = 0; j < 4; ++j) { const f32x4 w = wp[64 * j]; d += (v[j].x * w.x + v[j].y * w.y) + (v[j].z * w.z + v[j].w * w.w); }
                d = wave_sum(d); if (lane == g) myv = d; }
            if (lane < 8) { const int b = m >> 12, s_ = m & 4095, h = lane & 3; float pre = myv * rs;
                if (lane < 4) { pre += P.in[8][h]; LI[(size_t)(b * 4 + h) * SEQ + s_] = pre; }
                else { pre += P.in[9][h]; const float ls = fminf(pre, 0.f) - log1pf(__expf(-fabsf(pre))); LF[(size_t)(b * 4 + h) * SEQ + s_] = ls; } }
        }
    }
}

__device__ __forceinline__ void sgu_phase(const Params& P, LAS unsigned char* lds, int tid, int wave, int lane) {
    unsigned char* ws = P.ws; bf16_t* UG = (bf16_t*)(ws + WS_R1); const bf16_t* ZV = (const bf16_t*)(ws + WS_R2); const bf16_t* WSG = (const bf16_t*)(ws + WS_WSG);
    LAS float* meanL = (LAS float*)lds; LAS float* rstdL = meanL + 128;
    LAS bf16_t* WL = (LAS bf16_t*)(lds + 1024);
    LAS bf16_t* vnT = (LAS bf16_t*)(lds + 1024 + 34816);
    const int l16 = lane & 15, q4 = lane >> 4;
    for (int item = blockIdx.x; item < 512; item += gridDim.x) {
        const int g = item & 3, tb = (item >> 2) * 128;
        for (int i = 0; i < 16; ++i) { const int s = wave * 16 + i; const u32x4* rp = (const u32x4*)(ZV + (size_t)(tb + s) * 1024);
            float f[8], sm = 0.f, sq = 0.f; unpack8(rp[lane], f);
#pragma unroll
            for (int j = 0; j < 8; ++j) { sm += f[j]; sq += f[j] * f[j]; }
            unpack8(rp[64 + lane], f);
#pragma unroll
            for (int j = 0; j < 8; ++j) { sm += f[j]; sq += f[j] * f[j]; }
            sm = wave_sum(sm); sq = wave_sum(sq);
            const float mean = sm * (1.0f / 1024.0f); const float var = fmaxf(sq * (1.0f / 1024.0f) - mean * mean, 0.f);
            if (lane == 0) { meanL[s] = mean; rstdL[s] = 1.0f / sqrtf(var + 1e-5f); } }
#pragma unroll
        for (int i = 0; i < 4; ++i) { const int p = tid + 512 * i, row = p >> 4, c16 = p & 15; *(LAS u32x4*)(WL + row * 136 + 8 * c16) = *(const u32x4*)(WSG + (size_t)g * 16384 + row * 128 + 8 * c16); }
        __syncthreads();
        { const int s_lo = tid & 15, c8 = ((tid >> 4) & 3) + 4 * wave; float ng[8], nb[8];
#pragma unroll
          for (int j = 0; j < 8; ++j) { ng[j] = P.in[11][256 * g + 8 * c8 + j]; nb[j] = P.in[12][256 * g + 8 * c8 + j]; }
#pragma unroll
          for (int i = 0; i < 8; ++i) { const int s = s_lo + 16 * i; float f[8]; unpack8(*(const u32x4*)(ZV + (size_t)(tb + s) * 1024 + 256 * g + 8 * c8), f); const float mu = meanL[s], rs = rstdL[s];
#pragma unroll
              for (int j = 0; j < 8; ++j) { const float vn = (f[j] - mu) * rs * ng[j] + nb[j]; vnT[(8 * c8 + j) * 136 + s] = (bf16_t)(cvt_pk_bf16(vn, 0.f) & 0xffffu); } } }
        __syncthreads();
        f32x4 acc[8][2];
#pragma unroll
        for (int tt = 0; tt < 8; ++tt) { acc[tt][0] = (f32x4){0.f, 0.f, 0.f, 0.f}; acc[tt][1] = (f32x4){0.f, 0.f, 0.f, 0.f}; }
#pragma unroll
        for (int ks = 0; ks < 4; ++ks) {
            const bf16x8 y0 = *(const LAS bf16x8*)(vnT + (32 * wave + l16) * 136 + 32 * ks + 8 * q4), y1 = *(const LAS bf16x8*)(vnT + (32 * wave + 16 + l16) * 136 + 32 * ks + 8 * q4);
#pragma unroll
            for (int tt = 0; tt < 8; ++tt) { if (ks >= 2 && tt < 4) continue;
                const bf16x8 x = *(const LAS bf16x8*)(WL + (16 * tt + l16) * 136 + 32 * ks + 8 * q4);
                acc[tt][0] = __builtin_amdgcn_mfma_f32_16x16x32_bf16(x, y0, acc[tt][0], 0, 0, 0);
                acc[tt][1] = __builtin_amdgcn_mfma_f32_16x16x32_bf16(x, y1, acc[tt][1], 0, 0, 0); } }
#pragma unroll
        for (int tt = 0; tt < 8; ++tt)
#pragma unroll
            for (int r = 0; r < 4; ++r) { const int t = 16 * tt + 4 * q4 + r; const float bs = P.in[14][g * 128 + t];
#pragma unroll
                for (int cc = 0; cc < 2; ++cc) { const size_t idx = (size_t)(tb + t) * 1024 + 256 * g + 32 * wave + 16 * cc + l16; const float hs = bf2f(UG[idx]) * (acc[tt][cc][r] + bs); UG[idx] = (bf16_t)(cvt_pk_bf16(hs, 0.f) & 0xffffu); } }
        __syncthreads();
    }
}

__device__ __forceinline__ void m1_phase(const Params& P, LAS unsigned char* lds, int tid, int wave, int lane) {
    unsigned char* ws = P.ws;
    bf16_t* Q = (bf16_t*)(ws + WS_R2); bf16_t* K = (bf16_t*)(ws + WS_R3); bf16_t* V = (bf16_t*)(ws + WS_R4); const bf16_t* HALO = (const bf16_t*)(ws + WS_HALO);
    bf16_t* SB = (bf16_t*)(ws + WS_S); const float* LI = (const float*)(ws + WS_LI); const float* LF = (const float*)(ws + WS_LF);
    float* EN = (float*)(ws + WS_EN); float* RS = (float*)(ws + WS_RS); float* DEC = (float*)(ws + WS_DEC);
    LAS float* tabB = (LAS float*)lds; LAS float* tabG = tabB + 64; LAS float* sb = tabB + 128; LAS float* sli = tabB + 192; LAS float* smt = tabB + 256; LAS float* swi = tabB + 320; LAS float* swk = tabB + 384; LAS float* rsp = tabB + 448;
    LAS bf16_t* qL = (LAS bf16_t*)(lds + 4096);
    LAS bf16_t* kL = (LAS bf16_t*)(lds + 4096 + 33792);
    LAS bf16_t* vL = (LAS bf16_t*)(lds + 4096 + 2 * 33792);
    LAS bf16_t* SL = (LAS bf16_t*)(lds + 4096 + 3 * 33792);
    const int l16 = lane & 15, q4 = lane >> 4;
    for (int item = blockIdx.x; item < 1024; item += gridDim.x) {
        const int bh = item >> 6, c = item & 63, b = bh >> 2, h = bh & 3, t0 = b * SEQ + c * 64;
        const float* lfp = LF + (size_t)bh * SEQ; const float* lip = LI + (size_t)bh * SEQ;
        for (int cc = wave; cc < c; cc += NWAVE) { const float lf = lfp[cc * 64 + lane], li = lip[cc * 64 + lane]; const float bc = wave_scan_sum(lf, lane); const float bl = __shfl(bc, 63);
            const float gm = wave_max(bl - bc + li); if (lane == 0) { tabB[cc] = bl; tabG[cc] = gm; } }
        __syncthreads();
        if (wave == 0) {
            const float lf = lfp[c * 64 + lane], li = lip[c * 64 + lane]; const float bc = wave_scan_sum(lf, lane);
            float mc = 0.f; for (int cc = 0; cc < c; ++cc) mc = fmaxf(tabB[cc] + mc, tabG[cc]);
            const float a_int = bc + mc, pm = wave_scan_max(li - bc, lane), mt = fmaxf(a_int, bc + pm);
            const float bl = __shfl(bc, 63), g = bl - bc + li, mnew = fmaxf(bl + mc, wave_max(g));
            sb[lane] = bc; sli[lane] = li; smt[lane] = mt; swi[lane] = __expf(a_int - mt); swk[lane] = __expf(g - mnew);
            EN[(size_t)item * 64 + lane] = __expf(-mt); if (lane == 0) DEC[item] = __expf(bl + mc - mnew);
        }
        __syncthreads();
        { const int which = tid >> 8, rg = (tid >> 5) & 7, cg8 = tid & 31, col = 256 * h + 8 * cg8; const bf16_t* src = which ? K : Q;
          u32x4 xin[11];
#pragma unroll
          for (int rr = 0; rr < 11; ++rr) { const int t = 8 * rg + rr - 3;
              if (t >= 0) xin[rr] = *(const u32x4*)(src + (size_t)(t0 + t) * 1024 + col);
              else if (c > 0) xin[rr] = *(const u32x4*)(HALO + ((size_t)((t0 >> 6) - 1) * 3 + (t + 3)) * 2048 + which * 1024 + col);
              else xin[rr] = (u32x4){0u, 0u, 0u, 0u}; }
          float cw[4][8], cb[8];
#pragma unroll
          for (int j = 0; j < 8; ++j) { cb[j] = P.in[7][which * 1024 + col + j];
#pragma unroll
              for (int tap = 0; tap < 4; ++tap) cw[tap][j] = P.in[6][tap * 2048 + which * 1024 + col + j]; }
#pragma unroll
          for (int rr = 0; rr < 8; ++rr) { float y[8];
#pragma unroll
              for (int j = 0; j < 8; ++j) y[j] = cb[j];
#pragma unroll
              for (int tap = 0; tap < 4; ++tap) { float f[8]; unpack8(xin[rr + tap], f);
#pragma unroll
                  for (int j = 0; j < 8; ++j) y[j] += cw[tap][j] * f[j]; }
              const int t = 8 * rg + rr; const float sc = which ? 0.0625f : 1.0f;
#pragma unroll
              for (int j = 0; j < 8; ++j) y[j] = y[j] * pg8::sigm(y[j]) * sc;
              u32x4 w; w.x = cvt_pk_bf16(y[0], y[1]); w.y = cvt_pk_bf16(y[2], y[3]); w.z = cvt_pk_bf16(y[4], y[5]); w.w = cvt_pk_bf16(y[6], y[7]);
              *(LAS u32x4*)((which ? kL : qL) + t * 264 + 8 * cg8) = w;
              }
#pragma unroll
          for (int i = 0; i < 4; ++i) { const int p = tid + 512 * i, row = p >> 5, c16 = p & 31; *(LAS u32x4*)(vL + row * 264 + 8 * c16) = *(const u32x4*)(V + (size_t)(t0 + row) * 1024 + 256 * h + 8 * c16); }
          __syncthreads();
        }
        { const int tt = wave >> 1, sh = wave & 1; f32x4 a0 = (f32x4){0.f, 0.f, 0.f, 0.f}, a1 = a0;
#pragma unroll
          for (int kk = 0; kk < 8; ++kk) { const bf16x8 x = *(const LAS bf16x8*)(qL + (16 * tt + l16) * 264 + 32 * kk + 8 * q4);
              const bf16x8 y0 = *(const LAS bf16x8*)(kL + (32 * sh + l16) * 264 + 32 * kk + 8 * q4), y1 = *(const LAS bf16x8*)(kL + (32 * sh + 16 + l16) * 264 + 32 * kk + 8 * q4);
              a0 = __builtin_amdgcn_mfma_f32_16x16x32_bf16(x, y0, a0, 0, 0, 0); a1 = __builtin_amdgcn_mfma_f32_16x16x32_bf16(x, y1, a1, 0, 0, 0); }
          const int s0 = 32 * sh + l16, s1 = s0 + 16; const float e0 = sli[s0] - sb[s0], e1 = sli[s1] - sb[s1];
#pragma unroll
          for (int r = 0; r < 4; ++r) { const int t = 16 * tt + 4 * q4 + r; const float bt = sb[t] - smt[t];
              const float v0 = (s0 <= t) ? a0[r] * __expf(bt + e0) : 0.f, v1 = (s1 <= t) ? a1[r] * __expf(bt + e1) : 0.f;
              SL[t * 72 + s0] = (bf16_t)(cvt_pk_bf16(v0, 0.f) & 0xffffu); SL[t * 72 + s1] = (bf16_t)(cvt_pk_bf16(v1, 0.f) & 0xffffu);
              float rsum = v0 + v1; rsum += __shfl_xor(rsum, 1); rsum += __shfl_xor(rsum, 2); rsum += __shfl_xor(rsum, 4); rsum += __shfl_xor(rsum, 8);
              if (l16 == 0) rsp[t * 2 + sh] = rsum; } }
        __syncthreads();
        { const int row = tid >> 3, s8 = tid & 7; *(u32x4*)(SB + (size_t)item * 4096 + row * 64 + 8 * s8) = *(const LAS u32x4*)(SL + row * 72 + 8 * s8);
          if (tid < 64) RS[(size_t)item * 64 + tid] = rsp[2 * tid] + rsp[2 * tid + 1];
#pragma unroll
          for (int i = 0; i < 4; ++i) { const int p = tid + 512 * i, seg = p >> 5, d = seg * 4 + ((p & 31) >> 3), s8b = p & 7;
              float kv[8], vv[8];
#pragma unroll
              for (int j = 0; j < 8; ++j) { kv[j] = bf2f(kL[(8 * s8b + j) * 264 + d]) * swk[8 * s8b + j]; vv[j] = bf2f(vL[(8 * s8b + j) * 264 + d]); }
              u32x4 wk_, wv_; wk_.x = cvt_pk_bf16(kv[0], kv[1]); wk_.y = cvt_pk_bf16(kv[2], kv[3]); wk_.z = cvt_pk_bf16(kv[4], kv[5]); wk_.w = cvt_pk_bf16(kv[6], kv[7]);
              wv_.x = cvt_pk_bf16(vv[0], vv[1]); wv_.y = cvt_pk_bf16(vv[2], vv[3]); wv_.z = cvt_pk_bf16(vv[4], vv[5]); wv_.w = cvt_pk_bf16(vv[6], vv[7]);
              const size_t off = (size_t)(t0 + seg) * 1024 + 256 * h + (p & 31) * 8;
              *(u32x4*)(K + off) = wk_; *(u32x4*)(V + off) = wv_;
              float qv[8]; unpack8(*(const LAS u32x4*)(qL + seg * 264 + 8 * (p & 31)), qv); const float wi = swi[seg];
              u32x4 wq_; wq_.x = cvt_pk_bf16(qv[0] * wi, qv[1] * wi); wq_.y = cvt_pk_bf16(qv[2] * wi, qv[3] * wi); wq_.z = cvt_pk_bf16(qv[4] * wi, qv[5] * wi); wq_.w = cvt_pk_bf16(qv[6] * wi, qv[7] * wi);
              *(u32x4*)(Q + off) = wq_; } }
        __syncthreads();
    }
}

__device__ __forceinline__ void m2_phase(const Params& P, LAS unsigned char* lds, int tid, int wave, int lane) {
    if (blockIdx.x >= 64) return;
    unsigned char* ws = P.ws;
    const bf16_t* QS = (const bf16_t*)(ws + WS_R2); const bf16_t* KT = (const bf16_t*)(ws + WS_R3); const bf16_t* VT = (const bf16_t*)(ws + WS_R4); const bf16_t* SB = (const bf16_t*)(ws + WS_S);
    const float* EN = (const float*)(ws + WS_EN); const float* RS = (const float*)(ws + WS_RS); const float* DEC = (const float*)(ws + WS_DEC); bf16_t* HM = (bf16_t*)(ws + WS_R0);
    LAS bf16_t* qsL = (LAS bf16_t*)lds;
    LAS bf16_t* kwL = (LAS bf16_t*)(lds + 33792);
    LAS bf16_t* SL = (LAS bf16_t*)(lds + 70656);
    LAS bf16_t* vTL = (LAS bf16_t*)(lds + 79872);
    LAS float* nL = (LAS float*)(lds + 89088);
    LAS float* denL = (LAS float*)(lds + 91136);
    LAS float* rsL = (LAS float*)(lds + 91392);
    LAS float* enL = (LAS float*)(lds + 91648);
    LAS float* decL = (LAS float*)(lds + 92160);
    LAS f32x4* xch = (LAS f32x4*)(lds + 92416);
    const int bh = blockIdx.x >> 2, eq = blockIdx.x & 3, h = bh & 3, b = bh >> 2;
    const int eg = wave & 3, dh = wave >> 2, l16 = lane & 15, q4 = lane >> 4;
    f32x4 C[8];
#pragma unroll
    for (int i = 0; i < 8; ++i) C[i] = (f32x4){0.f, 0.f, 0.f, 0.f};
    float nreg = 0.f;
    if (tid < 256) nL[tid] = 0.f;
    if (tid < 64) decL[tid] = DEC[bh * 64 + tid];
    u32x4 rq[4], rk[4], rs_, rv; float rrs = 0.f, ren = 0.f;
#define M2_LOAD(cn) do { const int tb_ = b * SEQ + (cn) * 64; const size_t it_ = (size_t)bh * 64 + (cn); \
        _Pragma("unroll") for (int i = 0; i < 4; ++i) { const int p = tid + 512 * i; const size_t o_ = (size_t)(tb_ + (p >> 5)) * 1024 + 256 * h + 8 * (p & 31); rq[i] = *(const u32x4*)(QS + o_); rk[i] = *(const u32x4*)(KT + o_); } \
        rs_ = *(const u32x4*)(SB + it_ * 4096 + tid * 8); \
        { const int e_ = 64 * eq + (tid >> 3); rv = *(const u32x4*)(VT + (size_t)(tb_ + (e_ >> 2)) * 1024 + 256 * h + (e_ & 3) * 64 + 8 * (tid & 7)); } \
        if (tid < 64) { rrs = RS[it_ * 64 + tid]; ren = EN[it_ * 64 + tid]; } } while (0)
#define M2_STORE(cn) do { \
        _Pragma("unroll") for (int i = 0; i < 4; ++i) { const int p = tid + 512 * i; *(LAS u32x4*)(qsL + (p >> 5) * 264 + 8 * (p & 31)) = rq[i]; *(LAS u32x4*)(kwL + (p >> 3) * 72 + 8 * (p & 7)) = rk[i]; } \
        *(LAS u32x4*)(SL + (tid >> 3) * 72 + 8 * (tid & 7)) = rs_; *(LAS u32x4*)(vTL + (tid >> 3) * 72 + 8 * (tid & 7)) = rv; \
        if (tid < 64) { rsL[tid] = rrs; enL[((cn) & 1) * 64 + tid] = ren; } } while (0)
    M2_LOAD(0);
    M2_STORE(0);
    __syncthreads();
    for (int c = 0; c < 64; ++c) {
        if (c + 1 < 64) M2_LOAD(c + 1);
        const float dec = decL[c];
        const LAS float* nc = nL + (c & 1) * 256; LAS float* nn = nL + ((c + 1) & 1) * 256;
        { const int t = tid >> 3, part = tid & 7; float s = 0.f;
#pragma unroll
          for (int i = 0; i < 4; ++i) { float f[8]; unpack8(*(const LAS u32x4*)(qsL + t * 264 + 32 * part + 8 * i), f); const f32x4 n0 = *(const LAS f32x4*)(nc + 32 * part + 8 * i), n1 = *(const LAS f32x4*)(nc + 32 * part + 8 * i + 4);
              s += f[0] * n0[0] + f[1] * n0[1] + f[2] * n0[2] + f[3] * n0[3] + f[4] * n1[0] + f[5] * n1[1] + f[6] * n1[2] + f[7] * n1[3]; }
          s += __shfl_xor(s, 1); s += __shfl_xor(s, 2); s += __shfl_xor(s, 4);
          if (part == 0) denL[t] = s + rsL[t]; }
        if (tid < 256) { float s = 0.f;
#pragma unroll
            for (int i = 0; i < 8; ++i) { float f[8]; unpack8(*(const LAS u32x4*)(kwL + tid * 72 + 8 * i), f); s += ((f[0] + f[1]) + (f[2] + f[3])) + ((f[4] + f[5]) + (f[6] + f[7])); }
            nreg = dec * nreg + s; nn[tid] = nreg; }
        f32x4 num[4];
#pragma unroll
        for (int i = 0; i < 4; ++i) num[i] = (f32x4){0.f, 0.f, 0.f, 0.f};
#pragma unroll
        for (int k2 = 0; k2 < 4; ++k2) { const int kk = 4 * dh + k2;
            u32x4 yw; yw.x = cvt_pk_bf16(C[2 * k2][0], C[2 * k2][1]); yw.y = cvt_pk_bf16(C[2 * k2][2], C[2 * k2][3]); yw.z = cvt_pk_bf16(C[2 * k2 + 1][0], C[2 * k2 + 1][1]); yw.w = cvt_pk_bf16(C[2 * k2 + 1][2], C[2 * k2 + 1][3]);
            const bf16x8 y = __builtin_bit_cast(bf16x8, yw);
#pragma unroll
            for (int tt = 0; tt < 4; ++tt) { const LAS bf16_t* xp = qsL + (16 * tt + l16) * 264 + 32 * kk + 4 * q4; const u32x2 lo = *(const LAS u32x2*)xp, hi = *(const LAS u32x2*)(xp + 16);
                u32x4 xw; xw.x = lo.x; xw.y = lo.y; xw.z = hi.x; xw.w = hi.y;
                num[tt] = __builtin_amdgcn_mfma_f32_16x16x32_bf16(__builtin_bit_cast(bf16x8, xw), y, num[tt], 0, 0, 0); } }
        const bf16x8 yv0 = *(const LAS bf16x8*)(vTL + (16 * eg + l16) * 72 + 8 * q4), yv1 = *(const LAS bf16x8*)(vTL + (16 * eg + l16) * 72 + 32 + 8 * q4);
        { const bf16x8 yv = dh ? yv1 : yv0;
#pragma unroll
          for (int tt = 0; tt < 4; ++tt) { const bf16x8 x = *(const LAS bf16x8*)(SL + (16 * tt + l16) * 72 + 32 * dh + 8 * q4); num[tt] = __builtin_amdgcn_mfma_f32_16x16x32_bf16(x, yv, num[tt], 0, 0, 0); } }
#pragma unroll
        for (int i = 0; i < 8; ++i) { const int gdt = 8 * dh + i; C[i] = C[i] * dec;
            const bf16x8 x0 = *(const LAS bf16x8*)(kwL + (16 * gdt + l16) * 72 + 8 * q4), x1 = *(const LAS bf16x8*)(kwL + (16 * gdt + l16) * 72 + 32 + 8 * q4);
            C[i] = __builtin_amdgcn_mfma_f32_16x16x32_bf16(x0, yv0, C[i], 0, 0, 0); C[i] = __builtin_amdgcn_mfma_f32_16x16x32_bf16(x1, yv1, C[i], 0, 0, 0); }
        { const f32x4 s0 = dh ? num[0] : num[2], s1 = dh ? num[1] : num[3]; xch[(wave * 2 + 0) * 64 + lane] = s0; xch[(wave * 2 + 1) * 64 + lane] = s1; }
        __syncthreads();
        { const int wp = wave ^ 4; const f32x4 p0 = xch[(wp * 2 + 0) * 64 + lane], p1 = xch[(wp * 2 + 1) * 64 + lane];
          const f32x4 m0 = (dh ? num[2] : num[0]) + p0, m1 = (dh ? num[3] : num[1]) + p1;
          const int tb = b * SEQ + c * 64; const LAS float* enc = enL + (c & 1) * 64; const int ecol = 256 * h + 64 * eq + 16 * eg + l16;
#pragma unroll
          for (int r = 0; r < 4; ++r) { const int ta = 16 * (2 * dh) + 4 * q4 + r, tb2 = ta + 16;
              const float da = fmaxf(fabsf(denL[ta]), enc[ta]), db = fmaxf(fabsf(denL[tb2]), enc[tb2]);
              HM[(size_t)(tb + ta) * 1024 + ecol] = (bf16_t)(cvt_pk_bf16(m0[r] / da, 0.f) & 0xffffu);
              HM[(size_t)(tb + tb2) * 1024 + ecol] = (bf16_t)(cvt_pk_bf16(m1[r] / db, 0.f) & 0xffffu); } }
        if (c + 1 < 64) M2_STORE(c + 1);
        __syncthreads();
    }
#undef M2_LOAD
#undef M2_STORE
}

__device__ __forceinline__ void merge_phase(const Params& P, int wave, int lane) {
    unsigned char* ws = P.ws; const bf16_t* HM = (const bf16_t*)(ws + WS_R0); bf16_t* HS = (bf16_t*)(ws + WS_R1); const bf16_t* OGM = (const bf16_t*)(ws + WS_R5);
    const int gw = blockIdx.x * NWAVE + wave, NGW = gridDim.x * NWAVE;
    for (int m = gw; m < T; m += NGW) {
#pragma unroll
        for (int h = 0; h < 4; ++h) { const size_t off = (size_t)m * 1024 + 256 * h + 4 * lane;
            const u32x2 hw = *(const u32x2*)(HM + off), ow = *(const u32x2*)(OGM + off), sw = *(const u32x2*)(HS + off);
            const float x0 = bflo(hw.x), x1 = bfhi(hw.x), x2 = bflo(hw.y), x3 = bfhi(hw.y);
            const float mean = wave_sum((x0 + x1) + (x2 + x3)) * (1.0f / 256.0f);
            const float d0 = x0 - mean, d1 = x1 - mean, d2 = x2 - mean, d3 = x3 - mean;
            const float var = wave_sum((d0 * d0 + d1 * d1) + (d2 * d2 + d3 * d3)) * (1.0f / 256.0f); const float rs = 1.0f / sqrtf(var + 1e-5f);
            const f32x4 hg = *(const f32x4*)(P.in[10] + 256 * h + 4 * lane);
            const float o0 = bflo(ow.x) * d0 * rs * hg[0] + bflo(sw.x), o1 = bfhi(ow.x) * d1 * rs * hg[1] + bfhi(sw.x), o2 = bflo(ow.y) * d2 * rs * hg[2] + bflo(sw.y), o3 = bfhi(ow.y) * d3 * rs * hg[3] + bfhi(sw.y);
            u32x2 w; w.x = cvt_pk_bf16(o0, o1); w.y = cvt_pk_bf16(o2, o3); *(u32x2*)(HS + off) = w; }
    }
}
__device__ __forceinline__ void final_phase(const Params& P, int wave, int lane) {
    const int gw = blockIdx.x * NWAVE + wave, NGW = gridDim.x * NWAVE;
    for (int m = gw; m < T; m += NGW) {
        f32x4* xp = (f32x4*)(P.out + (size_t)m * D) + lane; f32x4 v[4]; float s = 0.f;
#pragma unroll
        for (int j = 0; j < 4; ++j) { v[j] = xp[64 * j]; s += (v[j].x * v[j].x + v[j].y * v[j].y) + (v[j].z * v[j].z + v[j].w * v[j].w); }
        s = wave_sum(s); const float rs = 1.0f / sqrtf(s * (1.0f / 1024.0f) + 1e-6f);
#pragma unroll
        for (int j = 0; j < 4; ++j) { const f32x4 g = *((const f32x4*)P.in[19] + lane + 64 * j); xp[64 * j] = v[j] * rs * g; }
    }
}

constexpr int NPHASE = 15;
__global__ void __launch_bounds__(NTHR) fwd_megakernel(Params P) {
    extern __shared__ __attribute__((aligned(16))) unsigned char lds_raw[];
    LAS unsigned char* lds = (LAS unsigned char*)lds_raw;
    cg::grid_group grid = cg::this_grid();
    const int tid = threadIdx.x, lane = tid & 63, wave = __builtin_amdgcn_readfirstlane(tid >> 6);
    unsigned char* ws = P.ws; const int lo = P.ph_lo, hi = P.ph_hi; const int G = gridDim.x, bx = blockIdx.x;
    float* rstd = (float*)(ws + WS_RSTD);
#ifndef PH_MASK
#define PH_MASK 0x7fff
#endif
#define IN(k) (((PH_MASK >> (k)) & 1) && lo <= (k) && (k) < hi)
#define SEAM(k) do { if (IN(k) && IN((k) + 1)) grid.sync(); } while (0)
    if (IN(0)) { p0_prologue(P, lds, tid, wave, lane); __syncthreads(); } SEAM(0);
    if (IN(1)) { pg8::Gemm g{(const bf16_t*)(ws + WS_R0), (const bf16_t*)(ws + WS_W1I), T, 2 * FF, D}; pg8::StaticOrder S; S.init(T, 2 * FF, G, bx);
        pg8::EpiSwiGLU E{(bf16_t*)(ws + WS_H), rstd, FF}; pg8::gemm_phase<pg8::EpiSwiGLU, pg8::StaticOrder>(lds, g, S, E, nullptr); } SEAM(1);
    if (IN(2)) { pg8::Gemm g{(const bf16_t*)(ws + WS_H), (const bf16_t*)(ws + WS_W1O), T, D, FF}; pg8::StaticOrder S; S.init(T, D, G, bx);
        pg8::EpiResid E{P.in[0], P.out, (bf16_t*)(ws + WS_R0), 0.5f}; pg8::gemm_phase<pg8::EpiResid, pg8::StaticOrder>(lds, g, S, E, nullptr); } SEAM(2);
    if (IN(3)) { row_phase(P, true, wave, lane); } SEAM(3);
    if (IN(4)) { pg8::Gemm g{(const bf16_t*)(ws + WS_R0), (const bf16_t*)(ws + WS_WMX), T, 3072, D}; pg8::StaticOrder S; S.init(T, 3072, G, bx);
        pg8::EpiMixA E{(bf16_t*)(ws + WS_R1), (bf16_t*)(ws + WS_R2), rstd}; pg8::gemm_phase<pg8::EpiMixA, pg8::StaticOrder>(lds, g, S, E, nullptr); } SEAM(4);
    if (IN(5)) { sgu_phase(P, lds, tid, wave, lane); } SEAM(5);
    if (IN(6)) { pg8::Gemm g{(const bf16_t*)(ws + WS_R0), (const bf16_t*)(ws + WS_WMX) + (size_t)3072 * D, T, 5120, D}; pg8::StaticOrder S; S.init(T, 5120, G, bx);
        pg8::EpiMixB E{(bf16_t*)(ws + WS_R2), (size_t)(16 * MiB), (bf16_t*)(ws + WS_R5), (bf16_t*)(ws + WS_HALO), rstd}; pg8::gemm_phase<pg8::EpiMixB, pg8::StaticOrder>(lds, g, S, E, nullptr); } SEAM(6);
    if (IN(7)) { m1_phase(P, lds, tid, wave, lane); } SEAM(7);
    if (IN(8)) { m2_phase(P, lds, tid, wave, lane); } SEAM(8);
    if (IN(9)) { merge_phase(P, wave, lane); } SEAM(9);
    if (IN(10)) { pg8::Gemm g{(const bf16_t*)(ws + WS_R1), (const bf16_t*)(ws + WS_WO), T, D, D}; pg8::StaticOrder S; S.init(T, D, G, bx);
        pg8::EpiResid E{P.out, P.out, (bf16_t*)(ws + WS_R0), 1.0f}; pg8::gemm_phase<pg8::EpiResid, pg8::StaticOrder>(lds, g, S, E, nullptr); } SEAM(10);
    if (IN(11)) { row_phase(P, false, wave, lane); } SEAM(11);
    if (IN(12)) { pg8::Gemm g{(const bf16_t*)(ws + WS_R0), (const bf16_t*)(ws + WS_W2I), T, 2 * FF, D}; pg8::StaticOrder S; S.init(T, 2 * FF, G, bx);
        pg8::EpiSwiGLU E{(bf16_t*)(ws + WS_H), rstd, FF}; pg8::gemm_phase<pg8::EpiSwiGLU, pg8::StaticOrder>(lds, g, S, E, nullptr); } SEAM(12);
    if (IN(13)) { pg8::Gemm g{(const bf16_t*)(ws + WS_H), (const bf16_t*)(ws + WS_W2O), T, D, FF}; pg8::StaticOrder S; S.init(T, D, G, bx);
        pg8::EpiResid E{P.out, P.out, nullptr, 0.5f}; pg8::gemm_phase<pg8::EpiResid, pg8::StaticOrder>(lds, g, S, E, nullptr); } SEAM(13);
    if (IN(14)) { final_phase(P, wave, lane); }
#undef IN
#undef SEAM
}

extern "C" void kernel_launch(void* const* d_in, const int* in_sizes, int n_in, void* d_out, int out_size, void* d_ws, size_t ws_size, hipStream_t stream) {
    static int grid = 0;
    if (grid == 0) {
        if (n_in != 20 || out_size != T * D || ws_size < WS_END) { fprintf(stderr, "kernel_launch: unexpected problem (n_in %d, out %d, ws %zu, need %zu)\n", n_in, out_size, ws_size, (size_t)WS_END); grid = -1; return; }
        int dev = 0, cus = 0, per_cu = 0;
        hipGetDevice(&dev); hipDeviceGetAttribute(&cus, hipDeviceAttributeMultiprocessorCount, dev);
        if (hipFuncSetAttribute((const void*)fwd_megakernel, hipFuncAttributeMaxDynamicSharedMemorySize, LDS_BYTES) != hipSuccess) { fprintf(stderr, "kernel_launch: hipFuncSetAttribute failed\n"); grid = -1; return; }
        if (hipOccupancyMaxActiveBlocksPerMultiprocessor(&per_cu, (const void*)fwd_megakernel, NTHR, LDS_BYTES) != hipSuccess || per_cu < 1) { fprintf(stderr, "kernel_launch: occupancy query says %d\n", per_cu); per_cu = 1; }
        (void)hipGetLastError();
        grid = cus * 1;
        fprintf(stderr, "kernel_launch: grid %d (cus %d, per_cu %d), ws %zu\n", grid, cus, per_cu, ws_size);
    }
    if (grid < 0) return;
    Params p{};
    for (int i = 0; i < 20; ++i) p.in[i] = (const float*)d_in[i];
    p.out = (float*)d_out; p.ws = (unsigned char*)d_ws;
#if MK_SINGLE
    p.ph_lo = 0; p.ph_hi = NPHASE;
    void* args[] = {&p};
    hipError_t e = hipLaunchCooperativeKernel((const void*)fwd_megakernel, dim3(grid), dim3(NTHR), args, LDS_BYTES, stream);
    if (e != hipSuccess) fprintf(stderr, "cooperative launch failed: %s (grid %d)\n", hipGetErrorString(e), grid);
#else
    for (int ph = 0; ph < NPHASE; ++ph) { p.ph_lo = ph; p.ph_hi = ph + 1; hipLaunchKernelGGL(fwd_megakernel, dim3(grid), dim3(NTHR), LDS_BYTES, stream, p); }
#endif
}
```

```cpp
#include <hip/hip_runtime.h>
#include <hip/hip_cooperative_groups.h>
#include <cstdio>
namespace cg = cooperative_groups;
#ifndef MK_SINGLE
#define MK_SINGLE 1
#endif
#include <hip/hip_runtime.h>
namespace pg8 {
#define PG8_LAS __attribute__((address_space(3)))
typedef unsigned short bf16_t;
typedef short bf16x8 __attribute__((ext_vector_type(8)));
typedef float f32x4 __attribute__((ext_vector_type(4)));
typedef unsigned u32x4 __attribute__((ext_vector_type(4)));
constexpr int BM = 256, BK = 64, HALF = 128, HTB = HALF * BK * 2  , STAGE_BYTES = 8 * HTB, NXCD = 8, WGM = 8;

__host__ __device__ __forceinline__ int lds_byte(int r, int c) { const int st = (r >> 4) * 2 + (c >> 5), rr = r & 15, cc = c & 31, ob = rr * 64 + cc * 2; return st * 1024 + (ob ^ (((ob >> 9) & 1) << 5)); }
__host__ __device__ __forceinline__ void stage_rc(int b, int& R, int& C) { const int st = b / 1024, sb = b % 1024, swz = sb ^ (((sb >> 9) & 1) << 5); R = (st >> 1) * 16 + swz / 64; C = (st & 1) * 32 + (swz % 64) / 2; }
__host__ __device__ __forceinline__ int perm32(int rho) { const int n = rho >> 4, i = rho & 15; return 8 * (i >> 2) + 4 * n + (i & 3); }

struct Unit { int pm, pn; };
struct Gemm { const bf16_t* A; const bf16_t* Bt; int M, N, K; };

struct StaticOrder {
    int nM, nN, nwg, G, c;
    __host__ __device__ void init(int M, int N, int G_, int c_) { nM = M / BM; nN = N / BM; nwg = nM * nN; G = G_; c = c_; }
    __host__ __device__ bool next(int i, Unit& u) const {
        const long L = (long)i * G + c; if (L >= nwg) return false;
        int wgid = (int)L; { const int q = nwg / NXCD, r = nwg % NXCD, xcd = wgid % NXCD, off = wgid / NXCD; wgid = (xcd < r ? xcd * (q + 1) : r * (q + 1) + (xcd - r) * q) + off; }
        const int nig = WGM * nN, gid = wgid / nig, fm = gid * WGM, gsz = (nM - fm) < WGM ? (nM - fm) : WGM;
        u.pm = fm + ((wgid % nig) % gsz); u.pn = (wgid % nig) / gsz; return true;
    }
    __device__ __forceinline__ void a_ready(const Unit&) const {}
    __device__ __forceinline__ void done(const Unit&) const {}
};

typedef float f32x2 __attribute__((ext_vector_type(2)));
typedef __bf16 bf16x2_t __attribute__((ext_vector_type(2)));
typedef unsigned u32x2 __attribute__((ext_vector_type(2)));
__device__ __forceinline__ unsigned cvt_pk_bf16(float lo, float hi) { f32x2 v = {lo, hi}; bf16x2_t b = __builtin_convertvector(v, bf16x2_t); return __builtin_bit_cast(unsigned, b); }
__device__ __forceinline__ f32x2 gelu_pk(f32x2 v) {
    const f32x2 av = __builtin_elementwise_abs(v), d = av * 0.2316418882f + 1.0f;
    f32x2 t; t.x = __builtin_amdgcn_rcpf(d.x); t.y = __builtin_amdgcn_rcpf(d.y);
    f32x2 q = t * 0.5307027145f + (-0.7265760135f); q = q * t + 0.7107068705f; q = q * t + (-0.142248368f); q = q * t + 0.127414796f; q = q * t;
    const f32x2 s = (v * v) * (-0.72134752044f);
    f32x2 e; e.x = __builtin_amdgcn_exp2f(s.x); e.y = __builtin_amdgcn_exp2f(s.y);
    const f32x2 m = v * (q * e), r = v - m;
    f32x2 o; o.x = v.x < 0.f ? m.x : r.x; o.y = v.y < 0.f ? m.y : r.y; return o;
}
__device__ __forceinline__ f32x4 gelu4(f32x4 v) { f32x2 a = gelu_pk((f32x2){v[0], v[1]}), b = gelu_pk((f32x2){v[2], v[3]}); return (f32x4){a.x, a.y, b.x, b.y}; }
__device__ __forceinline__ float sigm(float x) { return __builtin_amdgcn_rcpf(1.0f + __expf(-x)); }
__device__ __forceinline__ f32x4 sigm4(f32x4 v) { return (f32x4){sigm(v[0]), sigm(v[1]), sigm(v[2]), sigm(v[3])}; }
__device__ __forceinline__ u32x4 pack8(f32x4 a, f32x4 b) { u32x4 w; w.x = cvt_pk_bf16(a[0], a[1]); w.y = cvt_pk_bf16(a[2], a[3]); w.z = cvt_pk_bf16(b[0], b[1]); w.w = cvt_pk_bf16(b[2], b[3]); return w; }

struct EpiSwiGLU {
    static constexpr bool PERM = true, AFTER_DRAIN = false;
    bf16_t* H; const float* rstd; int ldh;
    __device__ __forceinline__ void operator()(const f32x4 (&acc)[2][2][4][2], const Unit& u, int wr, int wc, int fr, int fq) const {
        const int row0 = u.pm * BM + wr * 64 + fr, col0 = u.pn * 128 + wc * 32 + 8 * fq;
#pragma unroll
        for (int ai = 0; ai < 2; ++ai)
#pragma unroll
            for (int m = 0; m < 4; ++m) { const int row = row0 + ai * HALF + m * 16; const float rs = rstd[row];
                f32x4 h[2];
#pragma unroll
                for (int n = 0; n < 2; ++n) { const f32x4 g = acc[ai][0][m][n] * rs, up = acc[ai][1][m][n] * rs; h[n] = g * sigm4(g) * up; }
                *(u32x4*)(H + (size_t)row * ldh + col0) = pack8(h[0], h[1]); }
    }
};
struct EpiResid {
    static constexpr bool PERM = false, AFTER_DRAIN = false;
    const float* base; float* out; bf16_t* xb; float alpha;
    __device__ __forceinline__ void operator()(const f32x4 (&acc)[2][2][4][2], const Unit& u, int wr, int wc, int fr, int fq) const {
        const int row0 = u.pm * BM + wr * 64 + fr, col0 = u.pn * BM + wc * 32 + 4 * fq;
#pragma unroll
        for (int ai = 0; ai < 2; ++ai)
#pragma unroll
            for (int m = 0; m < 4; ++m) { const size_t off = (size_t)(row0 + ai * HALF + m * 16) * 1024 + col0;
#pragma unroll
                for (int bj = 0; bj < 2; ++bj)
#pragma unroll
                    for (int n = 0; n < 2; ++n) { const size_t o2 = off + bj * HALF + n * 16; const f32x4 bs = *(const f32x4*)(base + o2); const f32x4 o = bs + acc[ai][bj][m][n] * alpha;
                        *(f32x4*)(out + o2) = o;
                        if (xb) { u32x2 w; w.x = cvt_pk_bf16(o[0], o[1]); w.y = cvt_pk_bf16(o[2], o[3]); *(u32x2*)(xb + o2) = w; } } }
    }
};
struct EpiMixA {
    static constexpr bool PERM = true, AFTER_DRAIN = false;
    bf16_t* UG; bf16_t* ZV; const float* rstd;
    __device__ __forceinline__ void operator()(const f32x4 (&acc)[2][2][4][2], const Unit& u, int wr, int wc, int fr, int fq) const {
        const int row0 = u.pm * BM + wr * 64 + fr, cw = wc * 32 + 8 * fq;
#pragma unroll
        for (int ai = 0; ai < 2; ++ai)
#pragma unroll
            for (int m = 0; m < 4; ++m) { const int row = row0 + ai * HALF + m * 16; const float rs = rstd[row];
                if (u.pn < 8) {
                    f32x4 h[2];
#pragma unroll
                    for (int n = 0; n < 2; ++n) h[n] = gelu4(acc[ai][0][m][n] * rs) * sigm4(acc[ai][1][m][n] * rs);
                    *(u32x4*)(UG + (size_t)row * 1024 + u.pn * 128 + cw) = pack8(h[0], h[1]);
                } else {
#pragma unroll
                    for (int bj = 0; bj < 2; ++bj)
                        *(u32x4*)(ZV + (size_t)row * 1024 + (u.pn - 8) * 256 + bj * HALF + cw) = pack8(gelu4(acc[ai][bj][m][0] * rs), gelu4(acc[ai][bj][m][1] * rs));
                } }
    }
};
struct EpiMixB {
    static constexpr bool PERM = true, AFTER_DRAIN = false;
    bf16_t* QKV; size_t tstride; bf16_t* OGM; bf16_t* HALO; const float* rstd;
    __device__ __forceinline__ void operator()(const f32x4 (&acc)[2][2][4][2], const Unit& u, int wr, int wc, int fr, int fq) const {
        const int row0 = u.pm * BM + wr * 64 + fr, cw = wc * 32 + 8 * fq;
#pragma unroll
        for (int ai = 0; ai < 2; ++ai)
#pragma unroll
            for (int m = 0; m < 4; ++m) { const int row = row0 + ai * HALF + m * 16; const float rs = rstd[row];
                if (u.pn < 12) {
                    const int reg = u.pn >> 2, ct = (u.pn & 3) * 256;
#pragma unroll
                    for (int bj = 0; bj < 2; ++bj) { const u32x4 w = pack8(acc[ai][bj][m][0] * rs, acc[ai][bj][m][1] * rs); const int col = ct + bj * HALF + cw;
                        *(u32x4*)(QKV + (size_t)reg * tstride + (size_t)row * 1024 + col) = w;
                        if (reg < 2 && (row & 63) >= 61) *(u32x4*)(HALO + ((size_t)(row >> 6) * 3 + ((row & 63) - 61)) * 2048 + reg * 1024 + col) = w; }
                } else {
                    f32x4 h[2];
#pragma unroll
                    for (int n = 0; n < 2; ++n) h[n] = sigm4(acc[ai][0][m][n] * rs) * sigm4(acc[ai][1][m][n] * rs);
                    *(u32x4*)(OGM + (size_t)row * 1024 + (u.pn - 12) * 128 + cw) = pack8(h[0], h[1]);
                } }
    }
};

template <class Epi, class Sched, bool STAMP = false>
__device__ __forceinline__ void gemm_phase(PG8_LAS unsigned char* lds, const Gemm g, const Sched& S, const Epi& E, unsigned long long* stamps) {
    const int tid = threadIdx.x, wid = __builtin_amdgcn_readfirstlane(tid >> 6), lane = tid & 63, wr = wid >> 2, wc = wid & 3, fr = lane & 15, fq = lane >> 4;
    const int K = g.K, nt = K / BK;
    int ts_lo = 0, ts_hi = 0, nts = 0; const unsigned long long rt_entry = STAMP ? (unsigned long long)wall_clock64() : 0ull;
#define PG8_STAMP() do { if (STAMP && wid == 0 && nts < 64) { const unsigned long long _c = (unsigned long long)clock64(); \
        ts_lo = (lane == nts) ? (int)(unsigned)_c : ts_lo; ts_hi = (lane == nts) ? (int)(unsigned)(_c >> 32) : ts_hi; ++nts; } } while (0)
    PG8_STAMP();
    unsigned voffA[2], voffB[2];
#pragma unroll
    for (int i = 0; i < 2; ++i) { int R, C; stage_rc(tid * 16 + i * 8192, R, C); const int Rb = Epi::PERM ? ((R & ~31) + perm32(R & 31)) : R;
        voffA[i] = (unsigned)(R * K + C) * 2u; voffB[i] = (unsigned)(Rb * K + C) * 2u; }
    const size_t kstep = (size_t)(BK * 2);
    const size_t hstep = (size_t)HALF * K * 2;
    const size_t tstep = 2 * hstep;
    const unsigned ldsw = (unsigned)wid * 1024u;
    const int aoff = lds_byte(wr * 64 + fr, fq * 8), boff = lds_byte(wc * 32 + fr, fq * 8);
#define PG8_SA(b, h) (((b) * 2 + (h)) * HTB)
#define PG8_SB(b, h) ((4 + (b) * 2 + (h)) * HTB)
#define PG8_STAGE(bufoff, gbase, voff) do { _Pragma("unroll") for (int _i = 0; _i < 2; ++_i) \
        __builtin_amdgcn_global_load_lds((const unsigned*)((const char*)(gbase) + (voff)[_i]), (PG8_LAS unsigned*)(lds + (bufoff) + ldsw + _i * 8192), 16, 0, 0); } while (0)
#define PG8_LDA(dst, b, h) do { _Pragma("unroll") for (int m = 0; m < 4; ++m) _Pragma("unroll") for (int k = 0; k < 2; ++k) dst[m][k] = *(const PG8_LAS bf16x8*)(lds + PG8_SA(b, h) + aoff + m * 2048 + k * 1024); } while (0)
#define PG8_LDB(dst, b, h) do { _Pragma("unroll") for (int n = 0; n < 2; ++n) _Pragma("unroll") for (int k = 0; k < 2; ++k) dst[n][k] = *(const PG8_LAS bf16x8*)(lds + PG8_SB(b, h) + boff + n * 2048 + k * 1024); } while (0)
#define PG8_MMA(ai, bj, At, Bt) do { __builtin_amdgcn_s_setprio(1); _Pragma("unroll") for (int m = 0; m < 4; ++m) _Pragma("unroll") for (int n = 0; n < 2; ++n) _Pragma("unroll") for (int k = 0; k < 2; ++k) \
        acc[ai][bj][m][n] = __builtin_amdgcn_mfma_f32_16x16x32_bf16(Bt[n][k], At[m][k], acc[ai][bj][m][n], 0, 0, 0); __builtin_amdgcn_s_setprio(0); } while (0)
#define PG8_WAIT_V(n) asm volatile("s_waitcnt vmcnt(" #n ")" ::: "memory")
#define PG8_WAIT_L(n) asm volatile("s_waitcnt lgkmcnt(" #n ")" ::: "memory")
#define PG8_BAR __builtin_amdgcn_s_barrier()
#define PG8_SCHED __builtin_amdgcn_sched_barrier(0)
    Unit cur, nxt; int ui = 0;
    if (!S.next(0, cur)) return;
    f32x4 acc[2][2][4][2];
#pragma unroll
    for (int a = 0; a < 2; ++a)
#pragma unroll
        for (int b = 0; b < 2; ++b)
#pragma unroll
            for (int m = 0; m < 4; ++m)
#pragma unroll
                for (int n = 0; n < 2; ++n) acc[a][b][m][n] = (f32x4){0.f, 0.f, 0.f, 0.f};
    bf16x8 At[4][2], B0[2][2], B1[2][2];
    const char* cA = (const char*)g.A + (size_t)cur.pm * tstep; const char* cB = (const char*)g.Bt + (size_t)cur.pn * tstep;
    S.a_ready(cur);
    PG8_STAGE(PG8_SB(0, 0), cB, voffB); PG8_STAGE(PG8_SA(0, 0), cA, voffA); PG8_STAGE(PG8_SB(0, 1), cB + hstep, voffB); PG8_STAGE(PG8_SA(0, 1), cA + hstep, voffA);
    if (wr == 1) PG8_BAR;
    PG8_WAIT_V(4); PG8_BAR;
    PG8_STAGE(PG8_SB(1, 0), cB + kstep, voffB); PG8_STAGE(PG8_SA(1, 0), cA + kstep, voffA); PG8_STAGE(PG8_SB(1, 1), cB + hstep + kstep, voffB);
    PG8_WAIT_V(6); PG8_BAR;
    PG8_STAMP();
    for (;;) {
        const bool has_next = S.next(ui + 1, nxt);
        const char* nA = has_next ? (const char*)g.A + (size_t)nxt.pm * tstep : cA; const char* nB = has_next ? (const char*)g.Bt + (size_t)nxt.pn * tstep : cB;
        for (int t = 0; t < nt; t += 2) {
            const bool last = (t == nt - 2);
            const char* a1 = cA + (size_t)(t + 1) * kstep;
            const char* a2 = last ? nA : cA + (size_t)(t + 2) * kstep; const char* b2 = last ? nB : cB + (size_t)(t + 2) * kstep;
            const char* a3 = a2 + kstep; const char* b3 = b2 + kstep;
            if (last && has_next) S.a_ready(nxt);
            PG8_LDB(B0, 0, 0); PG8_SCHED; PG8_LDA(At, 0, 0); PG8_STAGE(PG8_SA(1, 1), a1 + hstep, voffA);
            PG8_WAIT_L(8); PG8_BAR; PG8_WAIT_L(0); PG8_MMA(0, 0, At, B0); PG8_BAR; PG8_SCHED;
            PG8_LDB(B1, 0, 1); PG8_STAGE(PG8_SB(0, 0), b2, voffB);
            PG8_BAR; PG8_WAIT_L(0); PG8_MMA(0, 1, At, B1); PG8_BAR;
            PG8_LDA(At, 0, 1); PG8_STAGE(PG8_SA(0, 0), a2, voffA);
            PG8_BAR; PG8_WAIT_L(0); PG8_MMA(1, 0, At, B0); PG8_BAR; PG8_SCHED;
            PG8_STAGE(PG8_SB(0, 1), b2 + hstep, voffB);
            PG8_WAIT_V(6); PG8_BAR; PG8_MMA(1, 1, At, B1); PG8_BAR;
            PG8_LDB(B0, 1, 0); PG8_SCHED; PG8_LDA(At, 1, 0); PG8_STAGE(PG8_SA(0, 1), a2 + hstep, voffA);
            PG8_WAIT_L(8); PG8_BAR; PG8_WAIT_L(0); PG8_MMA(0, 0, At, B0); PG8_BAR; PG8_SCHED;
            PG8_LDB(B1, 1, 1); PG8_STAGE(PG8_SB(1, 0), b3, voffB);
            PG8_BAR; PG8_WAIT_L(0); PG8_MMA(0, 1, At, B1); PG8_BAR;
            PG8_LDA(At, 1, 1); PG8_STAGE(PG8_SA(1, 0), a3, voffA);
            PG8_BAR; PG8_WAIT_L(0); PG8_MMA(1, 0, At, B0); PG8_BAR; PG8_SCHED;
            PG8_STAGE(PG8_SB(1, 1), b3 + hstep, voffB);
            PG8_WAIT_V(6); PG8_BAR; PG8_MMA(1, 1, At, B1); PG8_BAR;
        }
        PG8_STAMP();
        if constexpr (!Epi::AFTER_DRAIN) { E(acc, cur, wr, wc, fr, fq); S.done(cur); }
        PG8_STAMP();
        if (!has_next) break;
#pragma unroll
        for (int a = 0; a < 2; ++a)
#pragma unroll
            for (int b = 0; b < 2; ++b)
#pragma unroll
                for (int m = 0; m < 4; ++m)
#pragma unroll
                    for (int n = 0; n < 2; ++n) acc[a][b][m][n] = (f32x4){0.f, 0.f, 0.f, 0.f};
        cur = nxt; cA = nA; cB = nB; ++ui;
    }
    PG8_WAIT_V(0);
    if (wr == 0) PG8_BAR;
    PG8_BAR;
    if constexpr (Epi::AFTER_DRAIN) { E.fused(acc, cur, wr, wc, fr, fq, lds, wid, lane); S.done(cur); }
    PG8_STAMP();
    if (STAMP && wid == 0) { stamps[lane] = lane < nts ? (((unsigned long long)(unsigned)ts_hi << 32) | (unsigned)ts_lo) : 0ull;
        if (lane == 62) stamps[62] = rt_entry; if (lane == 63) stamps[63] = (unsigned long long)wall_clock64(); }
#undef PG8_STAMP
#undef PG8_SA
#undef PG8_SB
#undef PG8_STAGE
#undef PG8_LDA
#undef PG8_LDB
#undef PG8_MMA
#undef PG8_WAIT_V
#undef PG8_WAIT_L
#undef PG8_BAR
#undef PG8_SCHED
}
}

#define LAS __attribute__((address_space(3)))
#define XB_TMO      128
#define XB_XCNT(j)  (256  + 64 * (j))
#define XB_XSUB(j)  (1280 + 64 * (j))
#define XB_XGEN(j)  (2304 + 64 * (j))
#define XB_TOP      3328
#define XB_TOPGEN   3392
#define XCD_BAR_WORDS 3456
#define XB_SPIN_CAP (1u << 18)

__device__ __forceinline__ unsigned xb_ld(unsigned* p)              { return __hip_atomic_load(p, __ATOMIC_RELAXED, __HIP_MEMORY_SCOPE_AGENT); }
__device__ __forceinline__ unsigned xb_add(unsigned* p, unsigned v) { return __hip_atomic_fetch_add(p, v, __ATOMIC_RELAXED, __HIP_MEMORY_SCOPE_AGENT); }
__device__ __forceinline__ unsigned xb_xcc_id() { return (unsigned)__builtin_amdgcn_s_getreg((3 << 11) | 20) & 0xFu; }
#define XB_SPIN(cond, bar) do { unsigned _sp = 0; while (cond) { __builtin_amdgcn_s_sleep(1); \
    if ((++_sp & 255u) == 0u) { if (xb_ld(&(bar)[XB_TMO])) break; if (_sp > XB_SPIN_CAP) { atomicAdd(&(bar)[XB_TMO], 1u); break; } } } } while (0)

struct XcdBarrier {
    unsigned* bar; unsigned x;
    volatile LAS unsigned* st;
};

__device__ __forceinline__ XcdBarrier xcd_barrier_post(unsigned* bar, volatile LAS unsigned* st) {
    XcdBarrier b; b.bar = bar; b.x = xb_xcc_id(); b.st = st;
    if (threadIdx.x == 0) (void)xb_add(&bar[XB_XCNT(b.x)], 1u);
    return b;
}
__device__ __forceinline__ void xcd_barrier_complete(unsigned* bar, unsigned x, unsigned& nloc, unsigned& nx) {
    const unsigned G = gridDim.x * gridDim.y * gridDim.z;
    unsigned sum, cnt, mine, sp = 0u;
    for (;;) {
        sum = 0u; cnt = 0u; mine = 0u;
#pragma unroll
        for (unsigned j = 0; j < 16; ++j) { const unsigned c = xb_ld(&bar[XB_XCNT(j)]); sum += c; cnt += (c > 0u) ? 1u : 0u; mine = (j == x) ? c : mine; }
        if (sum == G) break;
        __builtin_amdgcn_s_sleep(1);
        if ((++sp & 255u) == 0u) { if (xb_ld(&bar[XB_TMO])) break; if (sp > XB_SPIN_CAP) { atomicAdd(&bar[XB_TMO], 1u); break; } }
    }
    nloc = mine > 0u ? mine : 1u; nx = cnt > 0u ? cnt : 1u;
}

__device__ __forceinline__ void xcd_barrier(const XcdBarrier& b) {
    asm volatile("s_waitcnt vmcnt(0)" ::: "memory");
    __syncthreads();
    if (threadIdx.x == 0) {
        unsigned* bar = b.bar;
        __builtin_amdgcn_s_waitcnt(0);
        unsigned nloc = b.st[0], nx = b.st[1];
        if (nloc == 0u) { xcd_barrier_complete(bar, b.x, nloc, nx); b.st[0] = nloc; b.st[1] = nx; }
        const unsigned old = xb_add(&bar[XB_XSUB(b.x)], 1u);
        const unsigned gen = old / nloc;
        if (old + 1u == (gen + 1u) * nloc) {
            __builtin_amdgcn_fence(__ATOMIC_RELEASE, "agent");
            asm volatile("s_waitcnt vmcnt(0)" ::: "memory");
            const unsigned og = xb_add(&bar[XB_TOP], 1u);
            const unsigned tg = og / nx;
            if (og + 1u == (tg + 1u) * nx) xb_add(&bar[XB_TOPGEN], 1u);
            else XB_SPIN(xb_ld(&bar[XB_TOPGEN]) == tg, bar);
            __builtin_amdgcn_fence(__ATOMIC_ACQUIRE, "agent");
            xb_add(&bar[XB_XGEN(b.x)], 1u);
            asm volatile("s_waitcnt vmcnt(0)" ::: "memory");
        } else {
            XB_SPIN(xb_ld(&bar[XB_XGEN(b.x)]) == gen, bar);
            __builtin_amdgcn_fence(__ATOMIC_ACQUIRE, "agent");
            asm volatile("s_waitcnt vmcnt(0)" ::: "memory");
        }
    }
    __syncthreads();
}

using pg8::bf16_t; using pg8::bf16x8; using pg8::f32x4; using pg8::u32x4; using pg8::f32x2; using pg8::u32x2; using pg8::cvt_pk_bf16;
constexpr int T = 16384, D = 1024, FF = 2816, SEQ = 4096, NTHR = 512, NWAVE = 8;
constexpr size_t MiB = 1u << 20;
constexpr size_t WS_R0 = 0 * MiB;
constexpr size_t WS_R1 = 32 * MiB;
constexpr size_t WS_R2 = 64 * MiB;
constexpr size_t WS_R3 = 96 * MiB;
constexpr size_t WS_R4 = 128 * MiB;
constexpr size_t WS_R5 = 160 * MiB;
constexpr size_t WS_H = 32 * MiB;
constexpr size_t WS_S = 192 * MiB;
constexpr size_t WS_W1I = 200 * MiB;
constexpr size_t WS_W1O = 211 * MiB;
constexpr size_t WS_WMX = WS_W1O + 5632 * 1024;
constexpr size_t WS_WO = WS_WMX + 16 * MiB;
constexpr size_t WS_W2I = WS_WO + 2 * MiB;
constexpr size_t WS_W2O = WS_W2I + 11 * MiB;
constexpr size_t WS_HALO = WS_W2O + 5632 * 1024;
constexpr size_t WS_LI = WS_HALO + 3 * MiB;
constexpr size_t WS_LF = WS_LI + 256 * 1024;
constexpr size_t WS_WIF = WS_LF + 256 * 1024;
constexpr size_t WS_WSG = WS_WIF + 32 * 1024;
constexpr size_t WS_RSTD = WS_WSG + 128 * 1024;
constexpr size_t WS_EN = WS_RSTD + 64 * 1024;
constexpr size_t WS_RS = WS_EN + 256 * 1024;
constexpr size_t WS_DEC = WS_RS + 256 * 1024;
constexpr size_t WS_BAR = WS_DEC + 4096;
constexpr size_t WS_END = WS_BAR + 16384;
static_assert(WS_END <= 256 * MiB, "workspace map exceeds 256 MiB");
constexpr int LDS_BYTES = 147456;

struct Params { const float* in[20]; float* out; unsigned char* ws; int ph_lo, ph_hi; };

__device__ __forceinline__ float bf2f(unsigned short b) { return __uint_as_float(((unsigned)b) << 16); }
__device__ __forceinline__ float bflo(unsigned w) { return __uint_as_float(w << 16); }
__device__ __forceinline__ float bfhi(unsigned w) { return __uint_as_float(w & 0xffff0000u); }
__device__ __forceinline__ void unpack8(const u32x4 w, float (&f)[8]) { f[0] = bflo(w.x); f[1] = bfhi(w.x); f[2] = bflo(w.y); f[3] = bfhi(w.y); f[4] = bflo(w.z); f[5] = bfhi(w.z); f[6] = bflo(w.w); f[7] = bfhi(w.w); }
__device__ __forceinline__ float wave_sum(float v) {
#pragma unroll
    for (int o = 1; o < 64; o <<= 1) v += __shfl_xor(v, o);
    return v; }
__device__ __forceinline__ float wave_max(float v) {
#pragma unroll
    for (int o = 1; o < 64; o <<= 1) v = fmaxf(v, __shfl_xor(v, o));
    return v; }
__device__ __forceinline__ float wave_scan_sum(float v, int lane) {
#pragma unroll
    for (int o = 1; o < 64; o <<= 1) { const float t = __shfl_up(v, o); if (lane >= o) v += t; }
    return v; }
__device__ __forceinline__ float wave_scan_max(float v, int lane) {
#pragma unroll
    for (int o = 1; o < 64; o <<= 1) { const float t = __shfl_up(v, o); if (lane >= o) v = fmaxf(v, t); }
    return v; }
#define LDS_FENCE() asm volatile("s_waitcnt lgkmcnt(0)" ::: "memory")

__device__ __forceinline__ int map_ffn_in(int n) { const int j = n >> 8, r = n & 255; return r < 128 ? 128 * j + r : FF + 128 * j + (r - 128); }
__device__ __forceinline__ int map_mix(int n) {
    if (n < 2048) { const int j = n >> 8, r = n & 255; return r < 128 ? 4104 + 128 * j + r : 7176 + 128 * j + (r - 128); }
    if (n < 3072) return 5128 + (n - 2048);
    n -= 3072;
    if (n < 3072) return n;
    n -= 3072; { const int j = n >> 8, r = n & 255; return r < 128 ? 3072 + 128 * j + r : 6152 + 128 * j + (r - 128); }
}
__device__ __forceinline__ void tr_item(const float* W, int Nsrc, int K, int k0, int srccol0, const float* ksc, bf16_t* WT, int n0, LAS float* scr, int lane) {
#pragma unroll
    for (int i = 0; i < 32; ++i) { const int kk = 2 * i + (lane >> 5); float v = W[(size_t)(k0 + kk) * Nsrc + srccol0 + (lane & 31)]; if (ksc) v *= ksc[k0 + kk]; scr[kk * 33 + (lane & 31)] = v; }
    LDS_FENCE();
    const int c = lane & 7;
#pragma unroll
    for (int j = 0; j < 4; ++j) { const int n = (lane >> 3) + 8 * j; const LAS float* s = scr + (8 * c) * 33 + n;
        u32x4 o; o.x = cvt_pk_bf16(s[0 * 33], s[1 * 33]); o.y = cvt_pk_bf16(s[2 * 33], s[3 * 33]); o.z = cvt_pk_bf16(s[4 * 33], s[5 * 33]); o.w = cvt_pk_bf16(s[6 * 33], s[7 * 33]);
        *(u32x4*)(WT + (size_t)(n0 + n) * K + k0 + 8 * c) = o; }
    LDS_FENCE();
}
__device__ __forceinline__ float row_rstd(const float* xrow, bf16_t* brow, int lane) {
    const f32x4* xr = (const f32x4*)xrow + lane; f32x4 v[4]; float s = 0.f;
#pragma unroll
    for (int j = 0; j < 4; ++j) { v[j] = xr[64 * j]; s += (v[j].x * v[j].x + v[j].y * v[j].y) + (v[j].z * v[j].z + v[j].w * v[j].w); }
    s = wave_sum(s);
    if (brow) { u32x2* o = (u32x2*)brow + lane;
#pragma unroll
        for (int j = 0; j < 4; ++j) { u32x2 w; w.x = cvt_pk_bf16(v[j].x, v[j].y); w.y = cvt_pk_bf16(v[j].z, v[j].w); o[64 * j] = w; } }
    return 1.0f / sqrtf(s * (1.0f / 1024.0f) + 1e-6f);
}
__device__ __forceinline__ void p0_prologue(const Params& P, LAS unsigned char* lds, int tid, int wave, int lane) {
    unsigned char* ws = P.ws;
    LAS float* scr = (LAS float*)(lds + wave * 16384);
    const int gw = blockIdx.x * NWAVE + wave, NGW = gridDim.x * NWAVE;
    constexpr int I1 = 16 * 176, I2 = 44 * 32, I3 = 16 * 256, I4 = 16 * 32;
    constexpr int NIT = 2 * I1 + 2 * I2 + I3 + I4;
    for (int it = gw; it < NIT; it += NGW) {
        int r = it;
        if (r < I1) { const int kb = r / 176, nb = r % 176; tr_item(P.in[2], 2 * FF, D, 64 * kb, map_ffn_in(32 * nb), P.in[1], (bf16_t*)(ws + WS_W1I), 32 * nb, scr, lane); continue; } r -= I1;
        if (r < I1) { const int kb = r / 176, nb = r % 176; tr_item(P.in[17], 2 * FF, D, 64 * kb, map_ffn_in(32 * nb), P.in[16], (bf16_t*)(ws + WS_W2I), 32 * nb, scr, lane); continue; } r -= I1;
        if (r < I2) { const int kb = r / 32, nb = r % 32; tr_item(P.in[3], D, FF, 64 * kb, 32 * nb, nullptr, (bf16_t*)(ws + WS_W1O), 32 * nb, scr, lane); continue; } r -= I2;
        if (r < I2) { const int kb = r / 32, nb = r % 32; tr_item(P.in[18], D, FF, 64 * kb, 32 * nb, nullptr, (bf16_t*)(ws + WS_W2O), 32 * nb, scr, lane); continue; } r -= I2;
        if (r < I3) { const int kb = r / 256, nb = r % 256; tr_item(P.in[5], 8200, D, 64 * kb, map_mix(32 * nb), P.in[4], (bf16_t*)(ws + WS_WMX), 32 * nb, scr, lane); continue; } r -= I3;
        { const int kb = r / 32, nb = r % 32; tr_item(P.in[15], D, D, 64 * kb, 32 * nb, nullptr, (bf16_t*)(ws + WS_WO), 32 * nb, scr, lane); }
    }
    { float* wif = (float*)(ws + WS_WIF); const float* wm = P.in[5]; const float* g = P.in[4];
      for (int i = blockIdx.x * NTHR + tid; i < 8 * 1024; i += gridDim.x * NTHR) { const int j = i >> 10, k = i & 1023; wif[i] = wm[(size_t)k * 8200 + 4096 + j] * g[k]; } }
    { bf16_t* wsg = (bf16_t*)(ws + WS_WSG); const float* w = P.in[13];
      for (int i = blockIdx.x * NTHR + tid; i < 4 * 128 * 128; i += gridDim.x * NTHR) { const int t = (i >> 7) & 127, s = i & 127; const float v = ((t >> 6) >= (s >> 6)) ? w[i] : 0.f; wsg[i] = (bf16_t)(cvt_pk_bf16(v, 0.f) & 0xffffu); } }
    { float* rstd = (float*)(ws + WS_RSTD); bf16_t* xb = (bf16_t*)(ws + WS_R0);
      for (int m = gw; m < T; m += NGW) { const float r = row_rstd(P.in[0] + (size_t)m * D, xb + (size_t)m * D, lane); if (lane == 0) rstd[m] = r; } }
}

__device__ __forceinline__ void row_phase(const Params& P, const bool gates, int wave, int lane) {
    unsigned char* ws = P.ws; float* rstd = (float*)(ws + WS_RSTD); const float* xr = P.out;
    const float* wif = (const float*)(ws + WS_WIF); float* LI = (float*)(ws + WS_LI); float* LF = (float*)(ws + WS_LF);
    const int gw = blockIdx.x * NWAVE + wave, NGW = gridDim.x * NWAVE;
    for (int m = gw; m < T; m += NGW) {
        const f32x4* xp = (const f32x4*)(xr + (size_t)m * D) + lane; f32x4 v[4]; float s = 0.f;
#pragma unroll
        for (int j = 0; j < 4; ++j) { v[j] = xp[64 * j]; s += (v[j].x * v[j].x + v[j].y * v[j].y) + (v[j].z * v[j].z + v[j].w * v[j].w); }
        s = wave_sum(s);
        const float rs = 1.0f / sqrtf(s * (1.0f / 1024.0f) + 1e-6f);
        if (lane == 0) rstd[m] = rs;
        if (gates) {
            float myv = 0.f;
#pragma unroll
            for (int g = 0; g < 8; ++g) { const f32x4* wp = (const f32x4*)(wif + g * 1024) + lane; float d = 0.f;
#pragma unroll
                for (int j = 0; j < 4; ++j) { const f32x4 w = wp[64 * j]; d += (v[j].x * w.x + v[j].y * w.y) + (v[j].z * w.z + v[j].w * w.w); }
                d = wave_sum(d); if (lane == g) myv = d; }
            if (lane < 8) { const int b = m >> 12, s_ = m & 4095, h = lane & 3; float pre = myv * rs;
                if (lane < 4) { pre += P.in[8][h]; LI[(size_t)(b * 4 + h) * SEQ + s_] = pre; }
                else { pre += P.in[9][h]; const float ls = fminf(pre, 0.f) - log1pf(__expf(-fabsf(pre))); LF[(size_t)(b * 4 + h) * SEQ + s_] = ls; } }
        }
    }
}

__device__ __forceinline__ void sgu_phase(const Params& P, LAS unsigned char* lds, int tid, int wave, int lane) {
    unsigned char* ws = P.ws; bf16_t* UG = (bf16_t*)(ws + WS_R1); const bf16_t* ZV = (const bf16_t*)(ws + WS_R2); const bf16_t* WSG = (const bf16_t*)(ws + WS_WSG);
    LAS float* meanL = (LAS float*)lds; LAS float* rstdL = meanL + 128;
    LAS bf16_t* WL = (LAS bf16_t*)(lds + 1024);
    LAS bf16_t* vnT = (LAS bf16_t*)(lds + 1024 + 34816);
    const int l16 = lane & 15, q4 = lane >> 4;
    for (int item = blockIdx.x; item < 512; item += gridDim.x) {
        const int g = item & 3, tb = (item >> 2) * 128;
        for (int i = 0; i < 16; ++i) { const int s = wave * 16 + i; const u32x4* rp = (const u32x4*)(ZV + (size_t)(tb + s) * 1024);
            float f[8], sm = 0.f, sq = 0.f; unpack8(rp[lane], f);
#pragma unroll
            for (int j = 0; j < 8; ++j) { sm += f[j]; sq += f[j] * f[j]; }
            unpack8(rp[64 + lane], f);
#pragma unroll
            for (int j = 0; j < 8; ++j) { sm += f[j]; sq += f[j] * f[j]; }
            sm = wave_sum(sm); sq = wave_sum(sq);
            const float mean = sm * (1.0f / 1024.0f); const float var = fmaxf(sq * (1.0f / 1024.0f) - mean * mean, 0.f);
            if (lane == 0) { meanL[s] = mean; rstdL[s] = 1.0f / sqrtf(var + 1e-5f); } }
#pragma unroll
        for (int i = 0; i < 4; ++i) { const int p = tid + 512 * i, row = p >> 4, c16 = p & 15; *(LAS u32x4*)(WL + row * 136 + 8 * c16) = *(const u32x4*)(WSG + (size_t)g * 16384 + row * 128 + 8 * c16); }
        __syncthreads();
        { const int s_lo = tid & 15, c8 = ((tid >> 4) & 3) + 4 * wave; float ng[8], nb[8];
#pragma unroll
          for (int j = 0; j < 8; ++j) { ng[j] = P.in[11][256 * g + 8 * c8 + j]; nb[j] = P.in[12][256 * g + 8 * c8 + j]; }
#pragma unroll
          for (int i = 0; i < 8; ++i) { const int s = s_lo + 16 * i; float f[8]; unpack8(*(const u32x4*)(ZV + (size_t)(tb + s) * 1024 + 256 * g + 8 * c8), f); const float mu = meanL[s], rs = rstdL[s];
#pragma unroll
              for (int j = 0; j < 8; ++j) { const float vn = (f[j] - mu) * rs * ng[j] + nb[j]; vnT[(8 * c8 + j) * 136 + s] = (bf16_t)(cvt_pk_bf16(vn, 0.f) & 0xffffu); } } }
        __syncthreads();
        f32x4 acc[8][2];
#pragma unroll
        for (int tt = 0; tt < 8; ++tt) { acc[tt][0] = (f32x4){0.f, 0.f, 0.f, 0.f}; acc[tt][1] = (f32x4){0.f, 0.f, 0.f, 0.f}; }
#pragma unroll
        for (int ks = 0; ks < 4; ++ks) {
            const bf16x8 y0 = *(const LAS bf16x8*)(vnT + (32 * wave + l16) * 136 + 32 * ks + 8 * q4), y1 = *(const LAS bf16x8*)(vnT + (32 * wave + 16 + l16) * 136 + 32 * ks + 8 * q4);
#pragma unroll
            for (int tt = 0; tt < 8; ++tt) { if (ks >= 2 && tt < 4) continue;
                const bf16x8 x = *(const LAS bf16x8*)(WL + (16 * tt + l16) * 136 + 32 * ks + 8 * q4);
                acc[tt][0] = __builtin_amdgcn_mfma_f32_16x16x32_bf16(x, y0, acc[tt][0], 0, 0, 0);
                acc[tt][1] = __builtin_amdgcn_mfma_f32_16x16x32_bf16(x, y1, acc[tt][1], 0, 0, 0); } }
#pragma unroll
        for (int tt = 0; tt < 8; ++tt)
#pragma unroll
            for (int r = 0; r < 4; ++r) { const int t = 16 * tt + 4 * q4 + r; const float bs = P.in[14][g * 128 + t];
#pragma unroll
                for (int cc = 0; cc < 2; ++cc) { const size_t idx = (size_t)(tb + t) * 1024 + 256 * g + 32 * wave + 16 * cc + l16; const float hs = bf2f(UG[idx]) * (acc[tt][cc][r] + bs); UG[idx] = (bf16_t)(cvt_pk_bf16(hs, 0.f) & 0xffffu); } }
        __syncthreads();
    }
}

__device__ __forceinline__ void m1_phase(const Params& P, LAS unsigned char* lds, int tid, int wave, int lane) {
    unsigned char* ws = P.ws;
    bf16_t* Q = (bf16_t*)(ws + WS_R2); bf16_t* K = (bf16_t*)(ws + WS_R3); bf16_t* V = (bf16_t*)(ws + WS_R4); const bf16_t* HALO = (const bf16_t*)(ws + WS_HALO);
    bf16_t* SB = (bf16_t*)(ws + WS_S); const float* LI = (const float*)(ws + WS_LI); const float* LF = (const float*)(ws + WS_LF);
    float* EN = (float*)(ws + WS_EN); float* RS = (float*)(ws + WS_RS); float* DEC = (float*)(ws + WS_DEC);
    LAS float* tabB = (LAS float*)lds; LAS float* tabG = tabB + 64; LAS float* sb = tabB + 128; LAS float* sli = tabB + 192; LAS float* smt = tabB + 256; LAS float* swi = tabB + 320; LAS float* swk = tabB + 384; LAS float* rsp = tabB + 448;
    LAS bf16_t* qL = (LAS bf16_t*)(lds + 4096);
    LAS bf16_t* kL = (LAS bf16_t*)(lds + 4096 + 33792);
    LAS bf16_t* vL = (LAS bf16_t*)(lds + 4096 + 2 * 33792);
    LAS bf16_t* SL = (LAS bf16_t*)(lds + 4096 + 3 * 33792);
    const int l16 = lane & 15, q4 = lane >> 4;
    for (int item = blockIdx.x; item < 1024; item += gridDim.x) {
        const int bh = item >> 6, c = item & 63, b = bh >> 2, h = bh & 3, t0 = b * SEQ + c * 64;
        const float* lfp = LF + (size_t)bh * SEQ; const float* lip = LI + (size_t)bh * SEQ;
        for (int cc = wave; cc < c; cc += NWAVE) { const float lf = lfp[cc * 64 + lane], li = lip[cc * 64 + lane]; const float bc = wave_scan_sum(lf, lane); const float bl = __shfl(bc, 63);
            const float gm = wave_max(bl - bc + li); if (lane == 0) { tabB[cc] = bl; tabG[cc] = gm; } }
        __syncthreads();
        if (wave == 0) {
            const float lf = lfp[c * 64 + lane], li = lip[c * 64 + lane]; const float bc = wave_scan_sum(lf, lane);
            float mc = 0.f; for (int cc = 0; cc < c; ++cc) mc = fmaxf(tabB[cc] + mc, tabG[cc]);
            const float a_int = bc + mc, pm = wave_scan_max(li - bc, lane), mt = fmaxf(a_int, bc + pm);
            const float bl = __shfl(bc, 63), g = bl - bc + li, mnew = fmaxf(bl + mc, wave_max(g));
            sb[lane] = bc; sli[lane] = li; smt[lane] = mt; swi[lane] = __expf(a_int - mt); swk[lane] = __expf(g - mnew);
            EN[(size_t)item * 64 + lane] = __expf(-mt); if (lane == 0) DEC[item] = __expf(bl + mc - mnew);
        }
        __syncthreads();
        { const int which = tid >> 8, rg = (tid >> 5) & 7, cg8 = tid & 31, col = 256 * h + 8 * cg8; const bf16_t* src = which ? K : Q;
          u32x4 xin[11];
#pragma unroll
          for (int rr = 0; rr < 11; ++rr) { const int t = 8 * rg + rr - 3;
              if (t >= 0) xin[rr] = *(const u32x4*)(src + (size_t)(t0 + t) * 1024 + col);
              else if (c > 0) xin[rr] = *(const u32x4*)(HALO + ((size_t)((t0 >> 6) - 1) * 3 + (t + 3)) * 2048 + which * 1024 + col);
              else xin[rr] = (u32x4){0u, 0u, 0u, 0u}; }
          float cw[4][8], cb[8];
#pragma unroll
          for (int j = 0; j < 8; ++j) { cb[j] = P.in[7][which * 1024 + col + j];
#pragma unroll
              for (int tap = 0; tap < 4; ++tap) cw[tap][j] = P.in[6][tap * 2048 + which * 1024 + col + j]; }
#pragma unroll
          for (int rr = 0; rr < 8; ++rr) { float y[8];
#pragma unroll
              for (int j = 0; j < 8; ++j) y[j] = cb[j];
#pragma unroll
              for (int tap = 0; tap < 4; ++tap) { float f[8]; unpack8(xin[rr + tap], f);
#pragma unroll
                  for (int j = 0; j < 8; ++j) y[j] += cw[tap][j] * f[j]; }
              const int t = 8 * rg + rr; const float sc = which ? 0.0625f : 1.0f;
#pragma unroll
              for (int j = 0; j < 8; ++j) y[j] = y[j] * pg8::sigm(y[j]) * sc;
              u32x4 w; w.x = cvt_pk_bf16(y[0], y[1]); w.y = cvt_pk_bf16(y[2], y[3]); w.z = cvt_pk_bf16(y[4], y[5]); w.w = cvt_pk_bf16(y[6], y[7]);
              *(LAS u32x4*)((which ? kL : qL) + t * 264 + 8 * cg8) = w;
              }
#pragma unroll
          for (int i = 0; i < 4; ++i) { const int p = tid + 512 * i, row = p >> 5, c16 = p & 31; *(LAS u32x4*)(vL + row * 264 + 8 * c16) = *(const u32x4*)(V + (size_t)(t0 + row) * 1024 + 256 * h + 8 * c16); }
          __syncthreads();
        }
        { const int tt = wave >> 1, sh = wave & 1; f32x4 a0 = (f32x4){0.f, 0.f, 0.f, 0.f}, a1 = a0;
#pragma unroll
          for (int kk = 0; kk < 8; ++kk) { const bf16x8 x = *(const LAS bf16x8*)(qL + (16 * tt + l16) * 264 + 32 * kk + 8 * q4);
              const bf16x8 y0 = *(const LAS bf16x8*)(kL + (32 * sh + l16) * 264 + 32 * kk + 8 * q4), y1 = *(const LAS bf16x8*)(kL + (32 * sh + 16 + l16) * 264 + 32 * kk + 8 * q4);
              a0 = __builtin_amdgcn_mfma_f32_16x16x32_bf16(x, y0, a0, 0, 0, 0); a1 = __builtin_amdgcn_mfma_f32_16x16x32_bf16(x, y1, a1, 0, 0, 0); }
          const int s0 = 32 * sh + l16, s1 = s0 + 16; const float e0 = sli[s0] - sb[s0], e1 = sli[s1] - sb[s1];
#pragma unroll
          for (int r = 0; r < 4; ++r) { const int t = 16 * tt + 4 * q4 + r; const float bt = sb[t] - smt[t];
              const float v0 = (s0 <= t) ? a0[r] * __expf(bt + e0) : 0.f, v1 = (s1 <= t) ? a1[r] * __expf(bt + e1) : 0.f;
              SL[t * 72 + s0] = (bf16_t)(cvt_pk_bf16(v0, 0.f) & 0xffffu); SL[t * 72 + s1] = (bf16_t)(cvt_pk_bf16(v1, 0.f) & 0xffffu);
              float rsum = v0 + v1; rsum += __shfl_xor(rsum, 1); rsum += __shfl_xor(rsum, 2); rsum += __shfl_xor(rsum, 4); rsum += __shfl_xor(rsum, 8);
              if (l16 == 0) rsp[t * 2 + sh] = rsum; } }
        __syncthreads();
        { const int row = tid >> 3, s8 = tid & 7; *(u32x4*)(SB + (size_t)item * 4096 + row * 64 + 8 * s8) = *(const LAS u32x4*)(SL + row * 72 + 8 * s8);
          if (tid < 64) RS[(size_t)item * 64 + tid] = rsp[2 * tid] + rsp[2 * tid + 1];
#pragma unroll
          for (int i = 0; i < 4; ++i) { const int p = tid + 512 * i, seg = p >> 5, d = seg * 4 + ((p & 31) >> 3), s8b = p & 7;
              float kv[8], vv[8];
#pragma unroll
              for (int j = 0; j < 8; ++j) { kv[j] = bf2f(kL[(8 * s8b + j) * 264 + d]) * swk[8 * s8b + j]; vv[j] = bf2f(vL[(8 * s8b + j) * 264 + d]); }
              u32x4 wk_, wv_; wk_.x = cvt_pk_bf16(kv[0], kv[1]); wk_.y = cvt_pk_bf16(kv[2], kv[3]); wk_.z = cvt_pk_bf16(kv[4], kv[5]); wk_.w = cvt_pk_bf16(kv[6], kv[7]);
              wv_.x = cvt_pk_bf16(vv[0], vv[1]); wv_.y = cvt_pk_bf16(vv[2], vv[3]); wv_.z = cvt_pk_bf16(vv[4], vv[5]); wv_.w = cvt_pk_bf16(vv[6], vv[7]);
              const size_t off = (size_t)(t0 + seg) * 1024 + 256 * h + (p & 31) * 8;
              *(u32x4*)(K + off) = wk_; *(u32x4*)(V + off) = wv_;
              float qv[8]; unpack8(*(const LAS u32x4*)(qL + seg * 264 + 8 * (p & 31)), qv); const float wi = swi[seg];
              u32x4 wq_; wq_.x = cvt_pk_bf16(qv[0] * wi, qv[1] * wi); wq_.y = cvt_pk_bf16(qv[2] * wi, qv[3] * wi); wq_.z = cvt_pk_bf16(qv[4] * wi, qv[5] * wi); wq_.w = cvt_pk_bf16(qv[6] * wi, qv[7] * wi);
              *(u32x4*)(Q + off) = wq_; } }
        __syncthreads();
    }
}

__device__ __forceinline__ void m2_phase(const Params& P, LAS unsigned char* lds, int tid, int wave, int lane) {
    if (blockIdx.x >= 64) return;
    unsigned char* ws = P.ws;
    const bf16_t* QS = (const bf16_t*)(ws + WS_R2); const bf16_t* KT = (const bf16_t*)(ws + WS_R3); const bf16_t* VT = (const bf16_t*)(ws + WS_R4); const bf16_t* SB = (const bf16_t*)(ws + WS_S);
    const float* EN = (const float*)(ws + WS_EN); const float* RS = (const float*)(ws + WS_RS); const float* DEC = (const float*)(ws + WS_DEC); bf16_t* HM = (bf16_t*)(ws + WS_R0);
    LAS bf16_t* qsL = (LAS bf16_t*)lds;
    LAS bf16_t* kwL = (LAS bf16_t*)(lds + 33792);
    LAS bf16_t* SL = (LAS bf16_t*)(lds + 70656);
    LAS bf16_t* vTL = (LAS bf16_t*)(lds + 79872);
    LAS float* nL = (LAS float*)(lds + 89088);
    LAS float* denL = (LAS float*)(lds + 91136);
    LAS float* rsL = (LAS float*)(lds + 91392);
    LAS float* enL = (LAS float*)(lds + 91648);
    LAS float* decL = (LAS float*)(lds + 92160);
    LAS f32x4* xch = (LAS f32x4*)(lds + 92416);
    const int bh = blockIdx.x >> 2, eq = blockIdx.x & 3, h = bh & 3, b = bh >> 2;
    const int eg = wave & 3, dh = wave >> 2, l16 = lane & 15, q4 = lane >> 4;
    f32x4 C[8];
#pragma unroll
    for (int i = 0; i < 8; ++i) C[i] = (f32x4){0.f, 0.f, 0.f, 0.f};
    float nreg = 0.f;
    if (tid < 256) nL[tid] = 0.f;
    if (tid < 64) decL[tid] = DEC[bh * 64 + tid];
    u32x4 rq[4], rk[4], rs_, rv; float rrs = 0.f, ren = 0.f;
#define M2_LOAD(cn) do { const int tb_ = b * SEQ + (cn) * 64; const size_t it_ = (size_t)bh * 64 + (cn); \
        _Pragma("unroll") for (int i = 0; i < 4; ++i) { const int p = tid + 512 * i; const size_t o_ = (size_t)(tb_ + (p >> 5)) * 1024 + 256 * h + 8 * (p & 31); rq[i] = *(const u32x4*)(QS + o_); rk[i] = *(const u32x4*)(KT + o_); } \
        rs_ = *(const u32x4*)(SB + it_ * 4096 + tid * 8); \
        { const int e_ = 64 * eq + (tid >> 3); rv = *(const u32x4*)(VT + (size_t)(tb_ + (e_ >> 2)) * 1024 + 256 * h + (e_ & 3) * 64 + 8 * (tid & 7)); } \
        if (tid < 64) { rrs = RS[it_ * 64 + tid]; ren = EN[it_ * 64 + tid]; } } while (0)
#define M2_STORE(cn) do { \
        _Pragma("unroll") for (int i = 0; i < 4; ++i) { const int p = tid + 512 * i; *(LAS u32x4*)(qsL + (p >> 5) * 264 + 8 * (p & 31)) = rq[i]; *(LAS u32x4*)(kwL + (p >> 3) * 72 + 8 * (p & 7)) = rk[i]; } \
        *(LAS u32x4*)(SL + (tid >> 3) * 72 + 8 * (tid & 7)) = rs_; *(LAS u32x4*)(vTL + (tid >> 3) * 72 + 8 * (tid & 7)) = rv; \
        if (tid < 64) { rsL[tid] = rrs; enL[((cn) & 1) * 64 + tid] = ren; } } while (0)
    M2_LOAD(0);
    M2_STORE(0);
    __syncthreads();
    for (int c = 0; c < 64; ++c) {
        if (c + 1 < 64) M2_LOAD(c + 1);
        const float dec = decL[c];
        const LAS float* nc = nL + (c & 1) * 256; LAS float* nn = nL + ((c + 1) & 1) * 256;
        { const int t = tid >> 3, part = tid & 7; float s = 0.f;
#pragma unroll
          for (int i = 0; i < 4; ++i) { float f[8]; unpack8(*(const LAS u32x4*)(qsL + t * 264 + 32 * part + 8 * i), f); const f32x4 n0 = *(const LAS f32x4*)(nc + 32 * part + 8 * i), n1 = *(const LAS f32x4*)(nc + 32 * part + 8 * i + 4);
              s += f[0] * n0[0] + f[1] * n0[1] + f[2] * n0[2] + f[3] * n0[3] + f[4] * n1[0] + f[5] * n1[1] + f[6] * n1[2] + f[7] * n1[3]; }
          s += __shfl_xor(s, 1); s += __shfl_xor(s, 2); s += __shfl_xor(s, 4);
          if (part == 0) denL[t] = s + rsL[t]; }
        if (tid < 256) { float s = 0.f;
#pragma unroll
            for (int i = 0; i < 8; ++i) { float f[8]; unpack8(*(const LAS u32x4*)(kwL + tid * 72 + 8 * i), f); s += ((f[0] + f[1]) + (f[2] + f[3])) + ((f[4] + f[5]) + (f[6] + f[7])); }
            nreg = dec * nreg + s; nn[tid] = nreg; }
        f32x4 num[4];
#pragma unroll
        for (int i = 0; i < 4; ++i) num[i] = (f32x4){0.f, 0.f, 0.f, 0.f};
#pragma unroll
        for (int k2 = 0; k2 < 4; ++k2) { const int kk = 4 * dh + k2;
            u32x4 yw; yw.x = cvt_pk_bf16(C[2 * k2][0], C[2 * k2][1]); yw.y = cvt_pk_bf16(C[2 * k2][2], C[2 * k2][3]); yw.z = cvt_pk_bf16(C[2 * k2 + 1][0], C[2 * k2 + 1][1]); yw.w = cvt_pk_bf16(C[2 * k2 + 1][2], C[2 * k2 + 1][3]);
            const bf16x8 y = __builtin_bit_cast(bf16x8, yw);
#pragma unroll
            for (int tt = 0; tt < 4; ++tt) { const LAS bf16_t* xp = qsL + (16 * tt + l16) * 264 + 32 * kk + 4 * q4; const u32x2 lo = *(const LAS u32x2*)xp, hi = *(const LAS u32x2*)(xp + 16);
                u32x4 xw; xw.x = lo.x; xw.y = lo.y; xw.z = hi.x; xw.w = hi.y;
                num[tt] = __builtin_amdgcn_mfma_f32_16x16x32_bf16(__builtin_bit_cast(bf16x8, xw), y, num[tt], 0, 0, 0); } }
        const bf16x8 yv0 = *(const LAS bf16x8*)(vTL + (16 * eg + l16) * 72 + 8 * q4), yv1 = *(const LAS bf16x8*)(vTL + (16 * eg + l16) * 72 + 32 + 8 * q4);
        { const bf16x8 yv = dh ? yv1 : yv0;
#pragma unroll
          for (int tt = 0; tt < 4; ++tt) { const bf16x8 x = *(const LAS bf16x8*)(SL + (16 * tt + l16) * 72 + 32 * dh + 8 * q4); num[tt] = __builtin_amdgcn_mfma_f32_16x16x32_bf16(x, yv, num[tt], 0, 0, 0); } }
#pragma unroll
        for (int i = 0; i < 8; ++i) { const int gdt = 8 * dh + i; C[i] = C[i] * dec;
            const bf16x8 x0 = *(const LAS bf16x8*)(kwL + (16 * gdt + l16) * 72 + 8 * q4), x1 = *(const LAS bf16x8*)(kwL + (16 * gdt + l16) * 72 + 32 + 8 * q4);
            C[i] = __builtin_amdgcn_mfma_f32_16x16x32_bf16(x0, yv0, C[i], 0, 0, 0); C[i] = __builtin_amdgcn_mfma_f32_16x16x32_bf16(x1, yv1, C[i], 0, 0, 0); }
        { const f32x4 s0 = dh ? num[0] : num[2], s1 = dh ? num[1] : num[3]; xch[(wave * 2 + 0) * 64 + lane] = s0; xch[(wave * 2 + 1) * 64 + lane] = s1; }
        __syncthreads();
        { const int wp = wave ^ 4; const f32x4 p0 = xch[(wp * 2 + 0) * 64 + lane], p1 = xch[(wp * 2 + 1) * 64 + lane];
          const f32x4 m0 = (dh ? num[2] : num[0]) + p0, m1 = (dh ? num[3] : num[1]) + p1;
          const int tb = b * SEQ + c * 64; const LAS float* enc = enL + (c & 1) * 64; const int ecol = 256 * h + 64 * eq + 16 * eg + l16;
#pragma unroll
          for (int r = 0; r < 4; ++r) { const int ta = 16 * (2 * dh) + 4 * q4 + r, tb2 = ta + 16;
              const float da = fmaxf(fabsf(denL[ta]), enc[ta]), db = fmaxf(fabsf(denL[tb2]), enc[tb2]);
              HM[(size_t)(tb + ta) * 1024 + ecol] = (bf16_t)(cvt_pk_bf16(m0[r] / da, 0.f) & 0xffffu);
              HM[(size_t)(tb + tb2) * 1024 + ecol] = (bf16_t)(cvt_pk_bf16(m1[r] / db, 0.f) & 0xffffu); } }
        if (c + 1 < 64) M2_STORE(c + 1);
        __syncthreads();
    }
#undef M2_LOAD
#undef M2_STORE
}

__device__ __forceinline__ void merge_phase(const Params& P, int wave, int lane) {
    unsigned char* ws = P.ws; const bf16_t* HM = (const bf16_t*)(ws + WS_R0); bf16_t* HS = (bf16_t*)(ws + WS_R1); const bf16_t* OGM = (const bf16_t*)(ws + WS_R5);
    const int gw = blockIdx.x * NWAVE + wave, NGW = gridDim.x * NWAVE;
    for (int m = gw; m < T; m += NGW) {
#pragma unroll
        for (int h = 0; h < 4; ++h) { const size_t off = (size_t)m * 1024 + 256 * h + 4 * lane;
            const u32x2 hw = *(const u32x2*)(HM + off), ow = *(const u32x2*)(OGM + off), sw = *(const u32x2*)(HS + off);
            const float x0 = bflo(hw.x), x1 = bfhi(hw.x), x2 = bflo(hw.y), x3 = bfhi(hw.y);
            const float mean = wave_sum((x0 + x1) + (x2 + x3)) * (1.0f / 256.0f);
            const float d0 = x0 - mean, d1 = x1 - mean, d2 = x2 - mean, d3 = x3 - mean;
            const float var = wave_sum((d0 * d0 + d1 * d1) + (d2 * d2 + d3 * d3)) * (1.0f / 256.0f); const float rs = 1.0f / sqrtf(var + 1e-5f);
            const f32x4 hg = *(const f32x4*)(P.in[10] + 256 * h + 4 * lane);
            const float o0 = bflo(ow.x) * d0 * rs * hg[0] + bflo(sw.x), o1 = bfhi(ow.x) * d1 * rs * hg[1] + bfhi(sw.x), o2 = bflo(ow.y) * d2 * rs * hg[2] + bflo(sw.y), o3 = bfhi(ow.y) * d3 * rs * hg[3] + bfhi(sw.y);
            u32x2 w; w.x = cvt_pk_bf16(o0, o1); w.y = cvt_pk_bf16(o2, o3); *(u32x2*)(HS + off) = w; }
    }
}
__device__ __forceinline__ void final_phase(const Params& P, int wave, int lane) {
    const int gw = blockIdx.x * NWAVE + wave, NGW = gridDim.x * NWAVE;
    for (int m = gw; m < T; m += NGW) {
        f32x4* xp = (f32x4*)(P.out + (size_t)m * D) + lane; f32x4 v[4]; float s = 0.f;
#pragma unroll
        for (int j = 0; j < 4; ++j) { v[j] = xp[64 * j]; s += (v[j].x * v[j].x + v[j].y * v[j].y) + (v[j].z * v[j].z + v[j].w * v[j].w); }
        s = wave_sum(s); const float rs = 1.0f / sqrtf(s * (1.0f / 1024.0f) + 1e-6f);
#pragma unroll
        for (int j = 0; j < 4; ++j) { const f32x4 g = *((const f32x4*)P.in[19] + lane + 64 * j); xp[64 * j] = v[j] * rs * g; }
    }
}

constexpr int NPHASE = 15;
__global__ void __launch_bounds__(NTHR) fwd_megakernel(Params P) {
    extern __shared__ __attribute__((aligned(16))) unsigned char lds_raw[];
    LAS unsigned char* lds = (LAS unsigned char*)lds_raw;
    cg::grid_group grid = cg::this_grid();
    const int tid = threadIdx.x, lane = tid & 63, wave = __builtin_amdgcn_readfirstlane(tid >> 6);
    unsigned char* ws = P.ws; const int lo = P.ph_lo, hi = P.ph_hi; const int G = gridDim.x, bx = blockIdx.x;
    float* rstd = (float*)(ws + WS_RSTD);
#ifndef PH_MASK
#define PH_MASK 0x7fff
#endif
#define IN(k) (((PH_MASK >> (k)) & 1) && lo <= (k) && (k) < hi)
    if (tid < 4) ((LAS unsigned*)(lds + LDS_BYTES - 16))[tid] = 0u;
    __syncthreads();
    XcdBarrier bar = xcd_barrier_post((unsigned*)(ws + WS_BAR), (volatile LAS unsigned*)(lds + LDS_BYTES - 16));
    if (hi > 1000) grid.sync();
#define SEAM(k) do { if (IN(k) && IN((k) + 1)) xcd_barrier(bar); } while (0)
    if (IN(0)) { p0_prologue(P, lds, tid, wave, lane); __syncthreads(); } SEAM(0);
    if (IN(1)) { pg8::Gemm g{(const bf16_t*)(ws + WS_R0), (const bf16_t*)(ws + WS_W1I), T, 2 * FF, D}; pg8::StaticOrder S; S.init(T, 2 * FF, G, bx);
        pg8::EpiSwiGLU E{(bf16_t*)(ws + WS_H), rstd, FF}; pg8::gemm_phase<pg8::EpiSwiGLU, pg8::StaticOrder>(lds, g, S, E, nullptr); } SEAM(1);
    if (IN(2)) { pg8::Gemm g{(const bf16_t*)(ws + WS_H), (const bf16_t*)(ws + WS_W1O), T, D, FF}; pg8::StaticOrder S; S.init(T, D, G, bx);
        pg8::EpiResid E{P.in[0], P.out, (bf16_t*)(ws + WS_R0), 0.5f}; pg8::gemm_phase<pg8::EpiResid, pg8::StaticOrder>(lds, g, S, E, nullptr); } SEAM(2);
    if (IN(3)) { row_phase(P, true, wave, lane); } SEAM(3);
    if (IN(4)) { pg8::Gemm g{(const bf16_t*)(ws + WS_R0), (const bf16_t*)(ws + WS_WMX), T, 3072, D}; pg8::StaticOrder S; S.init(T, 3072, G, bx);
        pg8::EpiMixA E{(bf16_t*)(ws + WS_R1), (bf16_t*)(ws + WS_R2), rstd}; pg8::gemm_phase<pg8::EpiMixA, pg8::StaticOrder>(lds, g, S, E, nullptr); } SEAM(4);
    if (IN(5)) { sgu_phase(P, lds, tid, wave, lane); } SEAM(5);
    if (IN(6)) { pg8::Gemm g{(const bf16_t*)(ws + WS_R0), (const bf16_t*)(ws + WS_WMX) + (size_t)3072 * D, T, 5120, D}; pg8::StaticOrder S; S.init(T, 5120, G, bx);
        pg8::EpiMixB E{(bf16_t*)(ws + WS_R2), (size_t)(16 * MiB), (bf16_t*)(ws + WS_R5), (bf16_t*)(ws + WS_HALO), rstd}; pg8::gemm_phase<pg8::EpiMixB, pg8::StaticOrder>(lds, g, S, E, nullptr); } SEAM(6);
    if (IN(7)) { m1_phase(P, lds, tid, wave, lane); } SEAM(7);
    if (IN(8)) { m2_phase(P, lds, tid, wave, lane); } SEAM(8);
    if (IN(9)) { merge_phase(P, wave, lane); } SEAM(9);
    if (IN(10)) { pg8::Gemm g{(const bf16_t*)(ws + WS_R1), (const bf16_t*)(ws + WS_WO), T, D, D}; pg8::StaticOrder S; S.init(T, D, G, bx);
        pg8::EpiResid E{P.out, P.out, (bf16_t*)(ws + WS_R0), 1.0f}; pg8::gemm_phase<pg8::EpiResid, pg8::StaticOrder>(lds, g, S, E, nullptr); } SEAM(10);
    if (IN(11)) { row_phase(P, false, wave, lane); } SEAM(11);
    if (IN(12)) { pg8::Gemm g{(const bf16_t*)(ws + WS_R0), (const bf16_t*)(ws + WS_W2I), T, 2 * FF, D}; pg8::StaticOrder S; S.init(T, 2 * FF, G, bx);
        pg8::EpiSwiGLU E{(bf16_t*)(ws + WS_H), rstd, FF}; pg8::gemm_phase<pg8::EpiSwiGLU, pg8::StaticOrder>(lds, g, S, E, nullptr); } SEAM(12);
    if (IN(13)) { pg8::Gemm g{(const bf16_t*)(ws + WS_H), (const bf16_t*)(ws + WS_W2O), T, D, FF}; pg8::StaticOrder S; S.init(T, D, G, bx);
        pg8::EpiResid E{P.out, P.out, nullptr, 0.5f}; pg8::gemm_phase<pg8::EpiResid, pg8::StaticOrder>(lds, g, S, E, nullptr); } SEAM(13);
    if (IN(14)) { final_phase(P, wave, lane); }
#undef IN
#undef SEAM
}

extern "C" void kernel_launch(void* const* d_in, const int* in_sizes, int n_in, void* d_out, int out_size, void* d_ws, size_t ws_size, hipStream_t stream) {
    static int grid = 0;
    if (grid == 0) {
        if (n_in != 20 || out_size != T * D || ws_size < WS_END) { fprintf(stderr, "kernel_launch: unexpected problem (n_in %d, out %d, ws %zu, need %zu)\n", n_in, out_size, ws_size, (size_t)WS_END); grid = -1; return; }
        int dev = 0, cus = 0, per_cu = 0;
        hipGetDevice(&dev); hipDeviceGetAttribute(&cus, hipDeviceAttributeMultiprocessorCount, dev);
        if (hipFuncSetAttribute((const void*)fwd_megakernel, hipFuncAttributeMaxDynamicSharedMemorySize, LDS_BYTES) != hipSuccess) { fprintf(stderr, "kernel_launch: hipFuncSetAttribute failed\n"); grid = -1; return; }
        if (hipOccupancyMaxActiveBlocksPerMultiprocessor(&per_cu, (const void*)fwd_megakernel, NTHR, LDS_BYTES) != hipSuccess || per_cu < 1) { fprintf(stderr, "kernel_launch: occupancy query says %d\n", per_cu); per_cu = 1; }
        (void)hipGetLastError();
        grid = cus * 1;
        fprintf(stderr, "kernel_launch: grid %d (cus %d, per_cu %d), ws %zu\n", grid, cus, per_cu, ws_size);
    }
    if (grid < 0) return;
    Params p{};
    for (int i = 0; i < 20; ++i) p.in[i] = (const float*)d_in[i];
    p.out = (float*)d_out; p.ws = (unsigned char*)d_ws;
#if MK_SINGLE
    if (hipMemsetAsync((unsigned char*)d_ws + WS_BAR, 0, 16384, stream) != hipSuccess) { fprintf(stderr, "kernel_launch: memset failed\n"); return; }
    p.ph_lo = 0; p.ph_hi = NPHASE;
    void* args[] = {&p};
    hipError_t e = hipLaunchCooperativeKernel((const void*)fwd_megakernel, dim3(grid), dim3(NTHR), args, LDS_BYTES, stream);
    if (e != hipSuccess) fprintf(stderr, "cooperative launch failed: %s (grid %d)\n", hipGetErrorString(e), grid);
#else
    for (int ph = 0; ph < NPHASE; ++ph) { p.ph_lo = ph; p.ph_hi = ph + 1; hipLaunchKernelGGL(fwd_megakernel, dim3(grid), dim3(NTHR), LDS_BYTES, stream, p); }
#endif
}
```
